# Optimizing an MI355X kernel written in HIP

```python
import math
import jax, jax.numpy as jnp
from jax import lax
import numpy as np


D_MODEL = 1024
BATCH = 4
SEQ = 4096
DEPTH = 4

GRID_W = 64
CTX_LEN = 256
N_BRANCH = 4
BRANCH_W = D_MODEL // 2

GDN_HEADS = 4
GDN_DK = BRANCH_W // GDN_HEADS
GDN_DV = BRANCH_W // GDN_HEADS
GDN_CONV = 4
GDN_CHUNK = 64

HY_W = BRANCH_W
HY_ORDER = 2
HY_CONV = 3
HY_EMB = 33
HY_BANDS = (HY_EMB - 1) // 2
HY_FH = 64
HY_DECAY_TARGET = 1e-2
HY_FAST_PCT = 0.3
HY_SLOW_PCT = 1.5
HY_MIN_DECAY = math.log(HY_DECAY_TARGET) / HY_SLOW_PCT
HY_MAX_DECAY = math.log(HY_DECAY_TARGET) / HY_FAST_PCT

GQA_HEADS = 4
GQA_KV = 2
GQA_HD = BRANCH_W // GQA_HEADS

DIFF_HEADS = 4
DIFF_HD = BRANCH_W // DIFF_HEADS
DIFF_QK = DIFF_HD // 2

Q_BLOCK = 128
ROPE_THETA = 10000.0
EPS = 1e-6
ALPHA = (2.0 * DEPTH) ** 0.25
BETA = (8.0 * DEPTH) ** -0.25

IN_SPLITS = (
    ('gdn_qkv', 3 * GDN_HEADS * GDN_DK), ('gdn_a', 2 * GDN_HEADS), ('gdn_b', 2 * GDN_HEADS), ('gdn_gate', BRANCH_W),
    ('hy_xv', 3 * HY_W), ('hy_gate', HY_W),
    ('gqa_q', GQA_HEADS * GQA_HD), ('gqa_k', GQA_KV * GQA_HD), ('gqa_v', GQA_KV * GQA_HD), ('gqa_gate', BRANCH_W),
    ('diff_q', DIFF_HEADS * 2 * DIFF_QK), ('diff_k', DIFF_HEADS * 2 * DIFF_QK), ('diff_v', DIFF_HEADS * DIFF_HD), ('diff_gate', BRANCH_W),
    ('merge', N_BRANCH * D_MODEL),
)
N_IN = (3 * GDN_HEADS * GDN_DK + 4 * GDN_HEADS + BRANCH_W + 4 * HY_W + 2 * GQA_HEADS * GQA_HD + 2 * GQA_KV * GQA_HD
        + 4 * DIFF_HEADS * DIFF_QK + DIFF_HEADS * DIFF_HD + BRANCH_W + N_BRANCH * D_MODEL)

kernel_name = 'hybrid_gated_merge_diffusion_trunk'

F32 = jnp.float32


def layer_norm(x):
    xf = x.astype(F32)
    mu = jnp.mean(xf, -1, keepdims=True)
    var = jnp.mean(jnp.square(xf - mu), -1, keepdims=True)
    return ((xf - mu) * lax.rsqrt(var + EPS)).astype(x.dtype)


def rms_norm(x, w):
    xf = x.astype(F32)
    y = xf * lax.rsqrt(jnp.mean(xf * xf, -1, keepdims=True) + EPS)
    return (y * w.astype(F32)).astype(x.dtype)


def l2norm(x):
    xf = x.astype(F32)
    return xf * lax.rsqrt(jnp.sum(xf * xf, -1, keepdims=True) + EPS)


def depthwise_conv(x, w):
    k = w.shape[0]
    pad_l = (k - 1) // 2
    return lax.conv_general_dilated(x, w.astype(x.dtype)[:, None, :], window_strides=(1,),
                                    padding=[(pad_l, k - 1 - pad_l)],
                                    dimension_numbers=('NWC', 'WIO', 'NWC'),
                                    feature_group_count=x.shape[-1])


def split_proj(p):
    out = {}
    off = 0
    for name, size in IN_SPLITS:
        out[name] = p[..., off:off + size]
        off += size
    return out


def axial_rope_tables(row, col, dim):
    half = dim // 2
    inv = ROPE_THETA ** (-jnp.arange(0, half, 2, dtype=F32) / half)
    ang = jnp.concatenate([row[:, None] * inv, col[:, None] * inv], -1)
    return jnp.cos(ang), jnp.sin(ang)


def apply_rope(x, cos, sin):
    xf = x.astype(F32)
    x1, x2 = xf[..., 0::2], xf[..., 1::2]
    cs, sn = cos[None, :, None, :], sin[None, :, None, :]
    return jnp.stack([x1 * cs - x2 * sn, x1 * sn + x2 * cs], -1).reshape(x.shape).astype(x.dtype)


def adaln_modulate(h, mod):
    shift, scale, gate = jnp.split(mod, 3, axis=-1)
    return layer_norm(h) * (1 + scale) + shift, gate


def post_norm(h, f, g, b):
    return layer_norm(ALPHA * h + f) * g + b


def gdn_prep(p, conv_w, a_log, dt_bias):
    qkv = jax.nn.silu(depthwise_conv(p['gdn_qkv'], conv_w))
    bsz, n = qkv.shape[:2]
    q, k, v = jnp.split(qkv, 3, axis=-1)
    q = l2norm(q.reshape(bsz, n, GDN_HEADS, GDN_DK)) * GDN_DK ** -0.5
    k = l2norm(k.reshape(bsz, n, GDN_HEADS, GDN_DK))
    v = v.reshape(bsz, n, GDN_HEADS, GDN_DV).astype(F32)
    a = p['gdn_a'].astype(F32).reshape(bsz, n, 2, GDN_HEADS)
    b = p['gdn_b'].astype(F32).reshape(bsz, n, 2, GDN_HEADS)
    g = -jnp.exp(a_log.astype(F32)) * jax.nn.softplus(a + dt_bias.astype(F32))
    return q, k, v, g, jax.nn.sigmoid(b)


def gdn_chunked(q, k, v, g, beta, s0, want_out):
    bsz, n_tok, nh, dk = q.shape
    dv = v.shape[-1]
    c = GDN_CHUNK
    nc = n_tok // c

    def chunks(t):
        return jnp.transpose(t.astype(F32).reshape(bsz, nc, c, nh, -1), (1, 0, 3, 2, 4))

    q, k, v = chunks(q), chunks(k), chunks(v)
    g = chunks(g[..., None])[..., 0]
    beta = chunks(beta[..., None])[..., 0]
    cum = jnp.cumsum(g, axis=-1)
    incl = jnp.tril(jnp.ones((c, c), dtype=bool))
    strict = jnp.tril(jnp.ones((c, c), dtype=bool), -1)
    decay = jnp.exp(jnp.where(incl, cum[..., :, None] - cum[..., None, :], -jnp.inf))
    kk = jnp.einsum('nbhid,nbhjd->nbhij', k, k)
    t_mat = jnp.where(strict, beta[..., :, None] * kk * decay, 0.0) + jnp.eye(c, dtype=F32)
    rhs = jnp.concatenate([k * (beta * jnp.exp(cum))[..., None], v * beta[..., None]], -1)
    sol = lax.linalg.triangular_solve(t_mat, rhs, left_side=True, lower=True, unit_diagonal=True)
    w_c, u_c = sol[..., :dk], sol[..., dk:]
    k_tail = k * jnp.exp(cum[..., -1:] - cum)[..., None]
    g_last = jnp.exp(cum[..., -1])
    xs = (w_c, u_c, k_tail, g_last)
    if want_out:
        q_dec = q * jnp.exp(cum)[..., None]
        qk = jnp.einsum('nbhid,nbhjd->nbhij', q, k) * decay
        xs = xs + (q_dec, qk)

    def step(s, inp):
        wc, uc, kt, gl = inp[:4]
        v_new = uc - jnp.einsum('bhck,bhkv->bhcv', wc, s)
        s_next = s * gl[..., None, None] + jnp.einsum('bhck,bhcv->bhkv', kt, v_new)
        if want_out:
            qd, qkc = inp[4], inp[5]
            o = jnp.einsum('bhck,bhkv->bhcv', qd, s) + jnp.einsum('bhcj,bhjv->bhcv', qkc, v_new)
            return s_next, o
        return s_next, None

    s_fin, o = lax.scan(step, s0, xs)
    if want_out:
        o = jnp.transpose(o, (1, 0, 3, 2, 4)).reshape(bsz, n_tok, nh, dv)
    return o, s_fin


def gdn_bidir(q, k, v, g, beta, s0_f, s0_b, want_out):
    flip = lambda t: t[:, ::-1]
    o_f, s_f = gdn_chunked(q, k, v, g[:, :, 0], beta[:, :, 0], s0_f, want_out)
    o_b, s_b = gdn_chunked(flip(q), flip(k), flip(v), flip(g[:, :, 1]), flip(beta[:, :, 1]), s0_b, want_out)
    o = o_f + flip(o_b) if want_out else None
    return o, s_f, s_b


def gdn_output(o, gate, w):
    y = rms_norm(o, w)
    return y.reshape(*gate.shape).astype(gate.dtype) * jax.nn.silu(gate)


def hyena_filter_spectrum(n, w1, b1, w2, b2, w3, b3, w4, freq):
    pos = jnp.arange(n, dtype=F32)
    t = pos / max(n - 1, 1)
    ang = (2.0 * math.pi / n) * pos[:, None] * jnp.linspace(1e-4, HY_BANDS - 1, HY_BANDS, dtype=F32)
    z = jnp.concatenate([t[:, None], jnp.cos(ang), -jnp.sin(ang)], -1)
    fr = freq.astype(F32)
    h = jnp.sin(fr * (z @ w1.astype(F32) + b1.astype(F32)))
    h = jnp.sin(fr * (h @ w2.astype(F32) + b2.astype(F32)))
    h = jnp.sin(fr * (h @ w3.astype(F32) + b3.astype(F32)))
    h = (h @ w4.astype(F32)).reshape(n, HY_ORDER, 2, HY_W)
    deltas = jnp.abs(jnp.linspace(HY_MIN_DECAY, HY_MAX_DECAY, HY_W, dtype=F32))
    h = h * jnp.exp(-t[:, None] * deltas)[:, None, None, :]
    full = jnp.concatenate([h[:, :, 0], jnp.zeros((1, HY_ORDER, HY_W), F32), h[:0:-1, :, 1]], 0)
    return jnp.fft.rfft(full, axis=0)


def hyena_mix(xv, gate, conv_w, spec, bias):
    x1, x2, v = jnp.split(depthwise_conv(xv, conv_w), 3, axis=-1)
    n = v.shape[1]

    def long_conv(z, o):
        zf = z.astype(F32)
        y = jnp.fft.irfft(jnp.fft.rfft(zf, n=2 * n, axis=1) * spec[None, :, o, :], n=2 * n, axis=1)[:, :n]
        return (y + zf * bias[o].astype(F32)).astype(z.dtype)

    z = x1 * long_conv(v, 0)
    z = x2 * long_conv(z, 1)
    return z * jax.nn.silu(gate)


def sweep_blocks(fn, q):
    bsz, n = q.shape[:2]
    nb = n // Q_BLOCK
    qb = jnp.moveaxis(q.reshape(bsz, nb, Q_BLOCK, *q.shape[2:]), 1, 0)
    out = lax.map(fn, qb)
    return jnp.moveaxis(out, 0, 1).reshape(bsz, n, *out.shape[3:])


def gqa_q(p, qn, rope):
    bsz, n = p['gqa_q'].shape[:2]
    q = rms_norm(p['gqa_q'].reshape(bsz, n, GQA_HEADS, GQA_HD), qn)
    return apply_rope(q, *rope) if rope is not None else q


def gqa_kv(p, kn, rope):
    bsz, n = p['gqa_k'].shape[:2]
    k = rms_norm(p['gqa_k'].reshape(bsz, n, GQA_KV, GQA_HD), kn)
    if rope is not None:
        k = apply_rope(k, *rope)
    return k, p['gqa_v'].reshape(bsz, n, GQA_KV, GQA_HD)


def gqa_attend(q, k, v):
    bsz, nq = q.shape[:2]
    qg = q.reshape(bsz, nq, GQA_KV, GQA_HEADS // GQA_KV, GQA_HD)
    s = jnp.einsum('bqkgd,bnkd->bkgqn', qg, k, preferred_element_type=F32) * GQA_HD ** -0.5
    pr = jax.nn.softmax(s, axis=-1).astype(v.dtype)
    return jnp.einsum('bkgqn,bnkd->bqkgd', pr, v).reshape(bsz, nq, GQA_HEADS * GQA_HD)


def diff_q(p, rope):
    bsz, n = p['diff_q'].shape[:2]
    q = p['diff_q'].reshape(bsz, n, DIFF_HEADS * 2, DIFF_QK)
    if rope is not None:
        q = apply_rope(q, *rope)
    return q.reshape(bsz, n, DIFF_HEADS, 2, DIFF_QK)


def diff_kv(p, rope):
    bsz, n = p['diff_k'].shape[:2]
    k = p['diff_k'].reshape(bsz, n, DIFF_HEADS * 2, DIFF_QK)
    if rope is not None:
        k = apply_rope(k, *rope)
    return k.reshape(bsz, n, DIFF_HEADS, 2, DIFF_QK), p['diff_v'].reshape(bsz, n, DIFF_HEADS, DIFF_HD)


def diff_attend(q, k, v, lam):
    s = jnp.einsum('bqhcd,bnhcd->bhcqn', q, k, preferred_element_type=F32) * DIFF_QK ** -0.5
    pr = jax.nn.softmax(s, axis=-1)
    w = (pr[:, :, 0] - lam * pr[:, :, 1]).astype(v.dtype)
    return jnp.einsum('bhqn,bnhd->bqhd', w, v)


def diff_output(o, gate, w, lam_init):
    y = rms_norm(o, w) * (1.0 - lam_init)
    return y.reshape(*gate.shape) * jax.nn.silu(gate)


def merge_branches(ys, merge_logits, w_br, w_out):
    y = jnp.stack(ys, axis=-2)
    proj = jnp.einsum('blnw,nwd->blnd', y, w_br)
    g = jax.nn.sigmoid(merge_logits.reshape(*merge_logits.shape[:-1], N_BRANCH, D_MODEL))
    return jnp.sum(g * proj, axis=-2) @ w_out


def setup_inputs(seed: int = 0) -> dict:
    key = jax.random.key(seed)
    ks = iter(jax.random.split(key, 40))
    nrm = lambda shape, std: std * jax.random.normal(next(ks), shape, F32)
    x = nrm((BATCH, SEQ, D_MODEL), 1.0)
    c = nrm((BATCH, D_MODEL), 1.0)
    ctx = nrm((BATCH, CTX_LEN, D_MODEL), 1.0)
    c_ctx = nrm((D_MODEL,), 1.0)
    w_ada = nrm((DEPTH, D_MODEL, 3 * D_MODEL), 0.5 * D_MODEL ** -0.5)
    b_ada = nrm((DEPTH, 3 * D_MODEL), 0.02)
    w_in = nrm((DEPTH, D_MODEL, N_IN), D_MODEL ** -0.5)
    gdn_conv = nrm((DEPTH, GDN_CONV, 3 * GDN_HEADS * GDN_DK), GDN_CONV ** -0.5)
    gdn_a_log = jnp.log(jax.random.uniform(next(ks), (DEPTH, 2, GDN_HEADS), F32, 1.0, 16.0))
    dt = jnp.exp(jax.random.uniform(next(ks), (DEPTH, 2, GDN_HEADS), F32, math.log(1e-3), math.log(1e-1)))
    gdn_dt_bias = dt + jnp.log(-jnp.expm1(-dt))
    gdn_norm = 1.0 + nrm((DEPTH, GDN_DV), 0.02)
    hy_conv = nrm((DEPTH, HY_CONV, 3 * HY_W), HY_CONV ** -0.5)
    hy_w1 = nrm((DEPTH, HY_EMB, HY_FH), HY_EMB ** -0.5)
    hy_b1 = nrm((DEPTH, HY_FH), 0.1)
    hy_w2 = nrm((DEPTH, HY_FH, HY_FH), HY_FH ** -0.5)
    hy_b2 = nrm((DEPTH, HY_FH), 0.1)
    hy_w3 = nrm((DEPTH, HY_FH, HY_FH), HY_FH ** -0.5)
    hy_b3 = nrm((DEPTH, HY_FH), 0.1)
    hy_w4 = nrm((DEPTH, HY_FH, HY_ORDER * 2 * HY_W), 0.1 * HY_FH ** -0.5)
    hy_freq = 1.0 + nrm((DEPTH, HY_FH), 0.1)
    hy_bias = nrm((DEPTH, HY_ORDER, HY_W), 0.1)
    gqa_qn = 1.0 + nrm((DEPTH, GQA_HD), 0.02)
    gqa_kn = 1.0 + nrm((DEPTH, GQA_HD), 0.02)
    diff_lam = nrm((DEPTH, 4, DIFF_QK), 0.1)
    diff_norm = 1.0 + nrm((DEPTH, DIFF_HD), 0.02)
    w_br = nrm((DEPTH, N_BRANCH, BRANCH_W, D_MODEL), BETA * BRANCH_W ** -0.5)
    w_out = nrm((DEPTH, D_MODEL, D_MODEL), BETA * D_MODEL ** -0.5)
    ln_g = 1.0 + nrm((DEPTH, D_MODEL), 0.02)
    ln_b = nrm((DEPTH, D_MODEL), 0.02)
    return {'x': x, 'c': c, 'ctx': ctx, 'c_ctx': c_ctx, 'w_ada': w_ada, 'b_ada': b_ada, 'w_in': w_in,
            'gdn_conv': gdn_conv, 'gdn_a_log': gdn_a_log, 'gdn_dt_bias': gdn_dt_bias, 'gdn_norm': gdn_norm,
            'hy_conv': hy_conv, 'hy_w1': hy_w1, 'hy_b1': hy_b1, 'hy_w2': hy_w2, 'hy_b2': hy_b2,
            'hy_w3': hy_w3, 'hy_b3': hy_b3, 'hy_w4': hy_w4, 'hy_freq': hy_freq, 'hy_bias': hy_bias,
            'gqa_qn': gqa_qn, 'gqa_kn': gqa_kn, 'diff_lam': diff_lam, 'diff_norm': diff_norm,
            'w_br': w_br, 'w_out': w_out, 'ln_g': ln_g, 'ln_b': ln_b}


def reference(x, c, ctx, c_ctx, w_ada, b_ada, w_in, gdn_conv, gdn_a_log, gdn_dt_bias, gdn_norm,
              hy_conv, hy_w1, hy_b1, hy_w2, hy_b2, hy_w3, hy_b3, hy_w4, hy_freq, hy_bias,
              gqa_qn, gqa_kn, diff_lam, diff_norm, w_br, w_out, ln_g, ln_b):
    n_lat = x.shape[1]
    n_ctx = ctx.shape[1]
    rows = n_lat // GRID_W
    row = jnp.repeat(jnp.arange(rows, dtype=F32), GRID_W)
    col = jnp.tile(jnp.arange(GRID_W, dtype=F32), rows)
    rope_gqa = axial_rope_tables(row, col, GQA_HD)
    rope_diff = axial_rope_tables(row, col, DIFF_QK)
    h_ctx, h_lat = ctx, x
    for l in range(DEPTH):
        want_ctx = l < DEPTH - 1
        lam_init = 0.8 - 0.6 * math.exp(-0.3 * l)
        mod_lat = (jax.nn.silu(c) @ w_ada[l] + b_ada[l])[:, None, :]
        mod_ctx = jax.nn.silu(c_ctx) @ w_ada[l] + b_ada[l]
        u_c, gate_c = adaln_modulate(h_ctx, mod_ctx)
        u_x, gate_x = adaln_modulate(h_lat, mod_lat)
        pc = split_proj(u_c @ w_in[l])
        px = split_proj(u_x @ w_in[l])

        qc, kc, vc, gc, bc = gdn_prep(pc, gdn_conv[l], gdn_a_log[l], gdn_dt_bias[l])
        qx, kx, vx, gx, bx = gdn_prep(px, gdn_conv[l], gdn_a_log[l], gdn_dt_bias[l])
        s0 = jnp.zeros((h_ctx.shape[0], GDN_HEADS, GDN_DK, GDN_DV), F32)
        oc, s_f, s_b = gdn_bidir(qc, kc, vc, gc, bc, s0, s0, want_ctx)
        ox, _, _ = gdn_bidir(qx, kx, vx, gx, bx, s_f, s_b, True)
        ya_x = gdn_output(ox, px['gdn_gate'], gdn_norm[l])

        spec_x = hyena_filter_spectrum(n_lat, hy_w1[l], hy_b1[l], hy_w2[l], hy_b2[l], hy_w3[l], hy_b3[l], hy_w4[l], hy_freq[l])
        yb_x = hyena_mix(px['hy_xv'], px['hy_gate'], hy_conv[l], spec_x, hy_bias[l])

        kgc, vgc = gqa_kv(pc, gqa_kn[l], None)
        kgx, vgx = gqa_kv(px, gqa_kn[l], rope_gqa)
        k_all = jnp.concatenate([kgc, kgx], axis=1)
        v_all = jnp.concatenate([vgc, vgx], axis=1)
        q_lat = gqa_q(px, gqa_qn[l], rope_gqa)
        yc_x = sweep_blocks(lambda qb: gqa_attend(qb, k_all, v_all), q_lat) * jax.nn.silu(px['gqa_gate'])

        lq1, lk1, lq2, lk2 = (diff_lam[l, i].astype(F32) for i in range(4))
        lam = jnp.exp(jnp.sum(lq1 * lk1)) - jnp.exp(jnp.sum(lq2 * lk2)) + lam_init
        kdc, vdc = diff_kv(pc, None)
        kdx, vdx = diff_kv(px, rope_diff)
        kd_all = jnp.concatenate([kdc, kdx], axis=1)
        vd_all = jnp.concatenate([vdc, vdx], axis=1)
        od_x = sweep_blocks(lambda qb: diff_attend(qb, kd_all, vd_all, lam), diff_q(px, rope_diff))
        yd_x = diff_output(od_x, px['diff_gate'], diff_norm[l], lam_init)

        out_x = merge_branches((ya_x, yb_x, yc_x, yd_x), px['merge'], w_br[l], w_out[l])
        new_lat = post_norm(h_lat, gate_x * out_x, ln_g[l], ln_b[l])

        if want_ctx:
            ya_c = gdn_output(oc, pc['gdn_gate'], gdn_norm[l])
            spec_c = hyena_filter_spectrum(n_ctx, hy_w1[l], hy_b1[l], hy_w2[l], hy_b2[l], hy_w3[l], hy_b3[l], hy_w4[l], hy_freq[l])
            yb_c = hyena_mix(pc['hy_xv'], pc['hy_gate'], hy_conv[l], spec_c, hy_bias[l])
            yc_c = gqa_attend(gqa_q(pc, gqa_qn[l], None), kgc, vgc) * jax.nn.silu(pc['gqa_gate'])
            yd_c = diff_output(diff_attend(diff_q(pc, None), kdc, vdc, lam), pc['diff_gate'], diff_norm[l], lam_init)
            out_c = merge_branches((ya_c, yb_c, yc_c, yd_c), pc['merge'], w_br[l], w_out[l])
            h_ctx = post_norm(h_ctx, gate_c * out_c, ln_g[l], ln_b[l])
        h_lat = new_lat
    return h_lat
```

```cpp
#include <hip/hip_runtime.h>
#include <hip/hip_cooperative_groups.h>
#include <stdint.h>
#include <stdio.h>
#include <string.h>
namespace cg = cooperative_groups;

#ifdef SK_SCAN
#define CALL_SCAN(x)
#else
#define CALL_SCAN(x) x
#endif
#ifdef SK_HY
#define CALL_HY(x)
#else
#define CALL_HY(x) x
#endif
#ifdef SK_PREP
#define CALL_PREP(x)
#else
#define CALL_PREP(x) x
#endif
#ifdef SK_FILT
#define CALL_FILT(x)
#else
#define CALL_FILT(x) x
#endif
#ifdef SK_E1
#define CALL_E1(x)
#else
#define CALL_E1(x) x
#endif
#ifdef SK_B
#define CALL_B(x)
#else
#define CALL_B(x) x
#endif
#ifdef SK_ATT
#define CALL_ATT(x)
#else
#define CALL_ATT(x) x
#endif

typedef unsigned short bf16_t;
typedef __attribute__((ext_vector_type(8))) short bf16x8;
typedef __attribute__((ext_vector_type(4))) float f32x4;

#define NLAT 16384
#define NCTX 1024
#define NTOK 17408
#define DM 1024
#define PS 5376
#define NKEY 4352
#define NIN 11792
#define SMEM_BYTES 71680
#define EPSV 1e-6f
#define ALPHA_DN 1.681792830507429f

#define C_GQKV 0
#define C_GGATE 1536
#define C_HGATE 2048
#define C_GQ 2560
#define C_GK 3072
#define C_GGT 3328
#define C_DQ 3840
#define C_DK 4352
#define C_DGT 4864
#define C_HXV 5376
#define C_GV 6912
#define C_DV 7168
#define C_AB 7680
#define C_MERGE 7696


#ifdef PROBE_HY2
#undef CALL_HY
#define CALL_HY(x) do { x; x; } while (0)
#endif
#ifdef PROBE_ATT2
#undef CALL_ATT
#define CALL_ATT(x) do { x; x; } while (0)
#endif
#ifdef PROBE_SCAN2
#undef CALL_SCAN
#define CALL_SCAN(x) do { x; x; } while (0)
#endif

union U128 { uint4 u; bf16x8 v; uint32_t w[4]; bf16_t h[8]; };
union U64 { uint2 u; uint32_t w[2]; bf16_t h[4]; };

typedef __bf16 hbf16x2_t __attribute__((ext_vector_type(2)));
typedef float hf32x2_t __attribute__((ext_vector_type(2)));
__device__ __forceinline__ uint32_t pk2(float a, float b) {
  hf32x2_t f = {a, b};
  hbf16x2_t h = __builtin_convertvector(f, hbf16x2_t);
  return __builtin_bit_cast(uint32_t, h);
}
__device__ __forceinline__ bf16_t f2bf(float f) { return (bf16_t)(pk2(f, 0.f) & 0xffffu); }
__device__ __forceinline__ float bf2f(bf16_t h) { return __uint_as_float(((unsigned)h) << 16); }
__device__ __forceinline__ float lo2f(uint32_t w) { return __uint_as_float(w << 16); }
__device__ __forceinline__ float hi2f(uint32_t w) { return __uint_as_float(w & 0xffff0000u); }
__device__ __forceinline__ f32x4 mfma16(bf16x8 a, bf16x8 b, f32x4 c) {
  return __builtin_amdgcn_mfma_f32_16x16x32_bf16(a, b, c, 0, 0, 0);
}
__device__ __forceinline__ float siluf(float x) { return x / (1.f + __expf(-x)); }
__device__ __forceinline__ float sigmf(float x) { return 1.f / (1.f + __expf(-x)); }
__device__ __forceinline__ float shx(float v, int lane, int o) {
  return __int_as_float(__builtin_amdgcn_ds_bpermute((lane ^ o) << 2, __float_as_int(v)));
}
__device__ __forceinline__ float wsum(float v, int lane) {
#pragma unroll
  for (int o = 32; o >= 1; o >>= 1) v += shx(v, lane, o);
  return v;
}

__device__ __forceinline__ int get_tid() { int t = threadIdx.x; asm volatile("" : "+v"(t)); return t; }

struct Params {
  const float *x, *c, *ctx, *c_ctx, *w_ada, *b_ada, *w_in, *gdn_conv, *gdn_a_log, *gdn_dt_bias, *gdn_norm,
      *hy_conv, *hy_w1, *hy_b1, *hy_w2, *hy_b2, *hy_w3, *hy_b3, *hy_w4, *hy_freq, *hy_bias,
      *gqa_qn, *gqa_kn, *diff_lam, *diff_norm, *w_br, *w_out, *ln_g, *ln_b;
  float* out;
  float* mod; float* hctx; bf16_t* winT; bf16_t* wbrT; bf16_t* woutT; bf16_t* filtL; bf16_t* filtC;
  bf16_t* u; bf16_t* p; bf16_t* xvT; bf16_t* gvT; bf16_t* dvT; float* ab;
  bf16_t *gW, *gQd, *gKtT, *gQK, *gUT; float* gGl;
  bf16_t* ogdn; bf16_t* ybraw; bf16_t* gqao; bf16_t* diffo;
  bf16_t* y; bf16_t* s; float* outf;
  unsigned* ctr; unsigned* xbar;
};

#define WINT(l) (P.winT + (size_t)((l) & 1) * NIN * DM)
#define WBRT(l) (P.wbrT + (size_t)((l) & 1) * 4 * 1024 * 512)
#define WOUTT(l) (P.woutT + (size_t)((l) & 1) * 1024 * 1024)
#define FILTL(l) (P.filtL + (size_t)((l) & 1) * 2 * 512 * 8192)
#define FILTC(l) (P.filtC + (size_t)((l) & 1) * 2 * 512 * 512)

__device__ __forceinline__ int win_orig_col(int n) {
  if (n < 1536) return n;
  if (n < 2048) return n - 1536 + 1552;
  if (n < 2560) return n - 2048 + 3600;
  if (n < 3072) return n - 2560 + 4112;
  if (n < 3328) return n - 3072 + 4624;
  if (n < 3840) return n - 3328 + 5136;
  if (n < 4352) return n - 3840 + 5648;
  if (n < 4864) return n - 4352 + 6160;
  if (n < 5376) return n - 4864 + 7184;
  if (n < 6912) return n - 5376 + 2064;
  if (n < 7168) return n - 6912 + 4880;
  if (n < 7680) return n - 7168 + 6672;
  if (n < 7696) return n - 7680 + 1536;
  return n;
}

__device__ __forceinline__ void mod_item(const Params& P, int it, unsigned char* smem) {
  float* sc = (float*)smem;
  float* red = sc + 5 * 1024;
  const int tid = get_tid(), lane = tid & 63, wv = tid >> 6;
  const int l = it / 48, cb = it % 48;
  __syncthreads();
  for (int e = tid; e < 5 * 1024; e += 256) {
    int v = e >> 10, k = e & 1023;
    float cv = (v < 4) ? P.c[v * 1024 + k] : P.c_ctx[k];
    sc[e] = siluf(cv);
  }
  __syncthreads();
  const float* w = P.w_ada + (size_t)l * 1024 * 3072 + cb * 64 + lane;
  float acc[5] = {0.f, 0.f, 0.f, 0.f, 0.f};
#pragma unroll 32
  for (int k = wv * 256; k < wv * 256 + 256; ++k) {
    float wv_ = w[(size_t)k * 3072];
#pragma unroll
    for (int v = 0; v < 5; ++v) acc[v] += sc[v * 1024 + k] * wv_;
  }
#pragma unroll
  for (int v = 0; v < 5; ++v) red[(wv * 5 + v) * 64 + lane] = acc[v];
  __syncthreads();
  for (int e = tid; e < 320; e += 256) {
    int v = e >> 6, j = e & 63;
    float s = red[(0 * 5 + v) * 64 + j] + red[(1 * 5 + v) * 64 + j] + red[(2 * 5 + v) * 64 + j] + red[(3 * 5 + v) * 64 + j];
    int col = cb * 64 + j;
    P.mod[((size_t)l * 5 + v) * 3072 + col] = s + P.b_ada[l * 3072 + col];
  }
}

__device__ __forceinline__ void convert_item(const Params& P, int l, int it, unsigned char* smem) {
  float* tile = (float*)smem;
  const int tid = get_tid();
  const float* src; bf16_t* dst; int Nsrc, K, N, nt, kt; bool mapc = false;
  if (it < 2960) { nt = it >> 4; kt = it & 15; src = P.w_in + (size_t)l * 1024 * NIN; Nsrc = NIN; K = 1024; N = NIN; dst = WINT(l); mapc = true; }
  else if (it < 2960 + 512) { int r = it - 2960; int br = r >> 7; r &= 127; nt = r >> 3; kt = r & 7;
    src = P.w_br + ((size_t)(l * 4 + br) * 512) * 1024; Nsrc = 1024; K = 512; N = 1024; dst = WBRT(l) + (size_t)br * 1024 * 512; }
  else { int r = it - 3472; nt = r >> 4; kt = r & 15; src = P.w_out + (size_t)l * 1024 * 1024; Nsrc = 1024; K = 1024; N = 1024; dst = WOUTT(l); }
  const int n0 = nt * 64, k0 = kt * 64;
  __syncthreads();
  {
    int n = tid & 63; int nn = n0 + n;
    int col = (nn < N) ? (mapc ? win_orig_col(nn) : nn) : -1;
#pragma unroll 4
    for (int i = 0; i < 16; ++i) {
      int k = i * 4 + (tid >> 6);
      tile[k * 65 + n] = (col >= 0) ? src[(size_t)(k0 + k) * Nsrc + col] : 0.f;
    }
  }
  __syncthreads();
  {
    int nl = tid >> 2, kc = (tid & 3) * 16;
    if (n0 + nl < N) {
      U128 a, b;
#pragma unroll
      for (int j = 0; j < 4; ++j) {
        a.w[j] = pk2(tile[(kc + 2 * j) * 65 + nl], tile[(kc + 2 * j + 1) * 65 + nl]);
        b.w[j] = pk2(tile[(kc + 8 + 2 * j) * 65 + nl], tile[(kc + 9 + 2 * j) * 65 + nl]);
      }
      uint4* d = (uint4*)(dst + (size_t)(n0 + nl) * K + k0 + kc);
      d[0] = a.u; d[1] = b.u;
    }
  }
}

__device__ __forceinline__ void convert4_item(const Params& P, int l, int it, unsigned char* smem) {
  float* tile = (float*)smem;
  const int tid = get_tid();
  const float* src; bf16_t* dst; int Nsrc, K, N, nt, kq; bool mapc = false;
  if (it < 740) { nt = it >> 2; kq = it & 3; src = P.w_in + (size_t)l * 1024 * NIN; Nsrc = NIN; K = 1024; N = NIN; dst = WINT(l); mapc = true; }
  else if (it < 740 + 128) { int r = it - 740; int br = r >> 5; r &= 31; nt = r >> 1; kq = r & 1;
    src = P.w_br + ((size_t)(l * 4 + br) * 512) * 1024; Nsrc = 1024; K = 512; N = 1024; dst = WBRT(l) + (size_t)br * 1024 * 512; }
  else { int r = it - 868; nt = r >> 2; kq = r & 3; src = P.w_out + (size_t)l * 1024 * 1024; Nsrc = 1024; K = 1024; N = 1024; dst = WOUTT(l); }
  const int n0 = nt * 64, k0 = kq * 256;
  __syncthreads();
  {
    const int n = tid & 63; const int nn = n0 + n;
    const int col = (nn < N) ? (mapc ? win_orig_col(nn) : nn) : -1;
    const float* sp = src + (size_t)(k0 + (tid >> 6)) * Nsrc + (col >= 0 ? col : 0);
    float* tp = tile + (tid >> 6) * 65 + n;
#pragma unroll 16
    for (int i = 0; i < 64; ++i) {
      float v = sp[(size_t)(i * 4) * Nsrc];
      tp[i * 4 * 65] = (col >= 0) ? v : 0.f;
    }
  }
  __syncthreads();
  {
    const int nl = tid >> 2, kc = (tid & 3) * 64;
    if (n0 + nl < N) {
      uint4* d = (uint4*)(dst + (size_t)(n0 + nl) * K + k0 + kc);
#pragma unroll
      for (int c8 = 0; c8 < 8; ++c8) {
        U128 a;
#pragma unroll
        for (int j = 0; j < 4; ++j)
          a.w[j] = pk2(tile[(kc + c8 * 8 + 2 * j) * 65 + nl], tile[(kc + c8 * 8 + 2 * j + 1) * 65 + nl]);
        d[c8] = a.u;
      }
    }
  }
}

__device__ __forceinline__ void filt_item(const Params& P, int l, int it, unsigned char* smem) {
  float* z = (float*)smem;
  float* ha = z + 528;
  float* hb = ha + 1024;
  const int tid = get_tid();
  int n, pos0; bf16_t* dst;
  if (it < 256) { n = 4096; pos0 = it * 16; dst = FILTL(l); } else { n = 256; pos0 = (it - 256) * 16; dst = FILTC(l); }
  const float* w1 = P.hy_w1 + l * 33 * 64; const float* b1 = P.hy_b1 + l * 64;
  const float* w2 = P.hy_w2 + l * 64 * 64; const float* b2 = P.hy_b2 + l * 64;
  const float* w3 = P.hy_w3 + l * 64 * 64; const float* b3 = P.hy_b3 + l * 64;
  const float* w4 = P.hy_w4 + (size_t)l * 64 * 2048; const float* fr = P.hy_freq + l * 64;
  __syncthreads();
  for (int e = tid; e < 16 * 33; e += 256) {
    int p = e / 33, j = e % 33; float pos = (float)(pos0 + p); float val;
    if (j == 0) val = pos / (float)(n - 1);
    else {
      int jj = (j - 1) & 15;
      float f = 1e-4f + (float)jj * ((15.f - 1e-4f) / 15.f);
      float ang = ((2.0f * 3.14159265358979323846f / (float)n) * pos) * f;
      val = (j <= 16) ? cosf(ang) : -sinf(ang);
    }
    z[e] = val;
  }
  __syncthreads();
  for (int e = tid; e < 1024; e += 256) {
    int p = e >> 6, m = e & 63; float a = b1[m];
    for (int j = 0; j < 33; ++j) a += z[p * 33 + j] * w1[j * 64 + m];
    ha[e] = sinf(fr[m] * a);
  }
  __syncthreads();
  for (int e = tid; e < 1024; e += 256) {
    int p = e >> 6, m = e & 63; float a = b2[m];
    for (int j = 0; j < 64; ++j) a += ha[p * 64 + j] * w2[j * 64 + m];
    hb[e] = sinf(fr[m] * a);
  }
  __syncthreads();
  for (int e = tid; e < 1024; e += 256) {
    int p = e >> 6, m = e & 63; float a = b3[m];
    for (int j = 0; j < 64; ++j) a += hb[p * 64 + j] * w3[j * 64 + m];
    ha[e] = sinf(fr[m] * a);
  }
  __syncthreads();
  const float dmin = -3.0701134573253945f, dmax = -15.350567286626973f;
  {
    float* wst = (float*)smem + 4096;
    const int p = tid >> 4, cs = tid & 15;
    const int lr = tid >> 5, lc = (tid & 31) * 4;
    const float* wsrc = w4 + (size_t)lr * 2048 + lc;
    float* wdst = wst + lr * 128 + lc;
#define FL_LD(i, g_) *(const float4*)(wsrc + (size_t)(8 * (i)) * 2048 + (g_) * 128)
    float4 pre0 = FL_LD(0, 0), pre1 = FL_LD(1, 0), pre2 = FL_LD(2, 0), pre3 = FL_LD(3, 0),
           pre4 = FL_LD(4, 0), pre5 = FL_LD(5, 0), pre6 = FL_LD(6, 0), pre7 = FL_LD(7, 0);
    const int pos = pos0 + p; const float t = (float)pos / (float)(n - 1);
#pragma unroll 1
    for (int grp = 0; grp < 16; ++grp) {
      __syncthreads();
      *(float4*)(wdst) = pre0; *(float4*)(wdst + 8 * 128) = pre1; *(float4*)(wdst + 16 * 128) = pre2; *(float4*)(wdst + 24 * 128) = pre3;
      *(float4*)(wdst + 32 * 128) = pre4; *(float4*)(wdst + 40 * 128) = pre5; *(float4*)(wdst + 48 * 128) = pre6; *(float4*)(wdst + 56 * 128) = pre7;
      __syncthreads();
      {
        const int gn = (grp + 1 < 16) ? grp + 1 : 15;
        pre0 = FL_LD(0, gn); pre1 = FL_LD(1, gn); pre2 = FL_LD(2, gn); pre3 = FL_LD(3, gn);
        pre4 = FL_LD(4, gn); pre5 = FL_LD(5, gn); pre6 = FL_LD(6, gn); pre7 = FL_LD(7, gn);
      }
      float acc[8];
#pragma unroll
      for (int j = 0; j < 8; ++j) acc[j] = 0.f;
#pragma unroll 8
      for (int m = 0; m < 64; ++m) {
        const float h = ha[p * 64 + m];
        const float4 wa = *(const float4*)(wst + m * 128 + cs * 8);
        const float4 wb = *(const float4*)(wst + m * 128 + cs * 8 + 4);
        acc[0] += h * wa.x; acc[1] += h * wa.y; acc[2] += h * wa.z; acc[3] += h * wa.w;
        acc[4] += h * wb.x; acc[5] += h * wb.y; acc[6] += h * wb.z; acc[7] += h * wb.w;
      }
#pragma unroll
      for (int j = 0; j < 8; ++j) {
        const int col = grp * 128 + cs * 8 + j;
        const int o = col >> 10, d = (col >> 9) & 1, c = col & 511;
        const float delta = -(dmin + (float)c * ((dmax - dmin) / 511.f));
        bf16_t* dd = dst + (size_t)(o * 512 + c) * (2 * n);
        const float val = acc[j] * __expf(-t * delta);
        if (d == 0) dd[n - pos] = f2bf(val);
        else { if (pos == 0) dd[0] = 0; else dd[n + pos] = f2bf(val); }
      }
    }
#undef FL_LD
  }
}

__device__ __forceinline__ void phase_rows(const Params& P, int l) {
  const int tid = get_tid(); const int wv = tid >> 6, lane = tid & 63;
  const int nrows = (l == 4) ? NLAT : NTOK;
  for (int row = blockIdx.x * 4 + wv; row < nrows; row += gridDim.x * 4) {
    const bool isctx = row >= NLAT;
    const int mi = isctx ? 4 : (row >> 12);
    float v[16];
    const float* src;
    if (l <= 1) src = isctx ? P.ctx + (size_t)(row - NLAT) * DM : P.x + (size_t)row * DM;
    else src = isctx ? P.hctx + (size_t)(row - NLAT) * DM : P.out + (size_t)row * DM;
#pragma unroll
    for (int j = 0; j < 4; ++j) {
      float4 t = *(const float4*)(src + j * 256 + lane * 4);
      v[4 * j] = t.x; v[4 * j + 1] = t.y; v[4 * j + 2] = t.z; v[4 * j + 3] = t.w;
    }
    if (l > 0) {
      const float* o = P.outf + (size_t)row * DM;
      const float* gate = P.mod + ((size_t)(l - 1) * 5 + mi) * 3072 + 2048;
      float sm = 0.f;
#pragma unroll
      for (int j = 0; j < 4; ++j) {
        float4 ov = *(const float4*)(o + j * 256 + lane * 4);
        float4 gv = *(const float4*)(gate + j * 256 + lane * 4);
        v[4 * j] = ALPHA_DN * v[4 * j] + gv.x * ov.x; v[4 * j + 1] = ALPHA_DN * v[4 * j + 1] + gv.y * ov.y;
        v[4 * j + 2] = ALPHA_DN * v[4 * j + 2] + gv.z * ov.z; v[4 * j + 3] = ALPHA_DN * v[4 * j + 3] + gv.w * ov.w;
        sm += v[4 * j] + v[4 * j + 1] + v[4 * j + 2] + v[4 * j + 3];
      }
      float mean = wsum(sm, lane) * (1.f / 1024.f);
      float sq = 0.f;
#pragma unroll
      for (int j = 0; j < 16; ++j) { float d = v[j] - mean; sq += d * d; }
      float rstd = rsqrtf(wsum(sq, lane) * (1.f / 1024.f) + EPSV);
      float* dstp = isctx ? P.hctx + (size_t)(row - NLAT) * DM : P.out + (size_t)row * DM;
      const float* lg = P.ln_g + (l - 1) * 1024; const float* lb = P.ln_b + (l - 1) * 1024;
#pragma unroll
      for (int j = 0; j < 4; ++j) {
        float4 g4 = *(const float4*)(lg + j * 256 + lane * 4);
        float4 b4 = *(const float4*)(lb + j * 256 + lane * 4);
        v[4 * j] = (v[4 * j] - mean) * rstd * g4.x + b4.x; v[4 * j + 1] = (v[4 * j + 1] - mean) * rstd * g4.y + b4.y;
        v[4 * j + 2] = (v[4 * j + 2] - mean) * rstd * g4.z + b4.z; v[4 * j + 3] = (v[4 * j + 3] - mean) * rstd * g4.w + b4.w;
        float4 t; t.x = v[4 * j]; t.y = v[4 * j + 1]; t.z = v[4 * j + 2]; t.w = v[4 * j + 3];
        *(float4*)(dstp + j * 256 + lane * 4) = t;
      }
    }
    if (l < 4) {
      float sm = 0.f;
#pragma unroll
      for (int j = 0; j < 16; ++j) sm += v[j];
      float mean = wsum(sm, lane) * (1.f / 1024.f);
      float sq = 0.f;
#pragma unroll
      for (int j = 0; j < 16; ++j) { float d = v[j] - mean; sq += d * d; }
      float rstd = rsqrtf(wsum(sq, lane) * (1.f / 1024.f) + EPSV);
      const float* md = P.mod + ((size_t)l * 5 + mi) * 3072;
#pragma unroll
      for (int j = 0; j < 4; ++j) {
        float4 sh = *(const float4*)(md + j * 256 + lane * 4);
        float4 scl = *(const float4*)(md + 1024 + j * 256 + lane * 4);
        float a0 = (v[4 * j] - mean) * rstd * (1.f + scl.x) + sh.x;
        float a1 = (v[4 * j + 1] - mean) * rstd * (1.f + scl.y) + sh.y;
        float a2 = (v[4 * j + 2] - mean) * rstd * (1.f + scl.z) + sh.z;
        float a3 = (v[4 * j + 3] - mean) * rstd * (1.f + scl.w) + sh.w;
        uint2 o2; o2.x = pk2(a0, a1); o2.y = pk2(a2, a3);
        *(uint2*)(P.u + (size_t)row * DM + j * 256 + lane * 4) = o2;
      }
    }
  }
}

__device__ __forceinline__ int lds_byte2(int r, int c) {
  int st = (r >> 4) * 2 + (c >> 5), ob = (r & 15) * 64 + (c & 31) * 2;
  return st * 1024 + (ob ^ (((ob >> 9) & 1) << 5));
}
__device__ __forceinline__ void stage_rc2(int b, int& R, int& C) {
  int st = b >> 10, sb = b & 1023, swz = sb ^ (((sb >> 9) & 1) << 5);
  R = (st >> 1) * 16 + swz / 64;
  C = (st & 1) * 32 + (swz % 64) / 2;
}
template <int BN>
__device__ __forceinline__ void gemm_tile(const bf16_t* __restrict__ A, int lda, const bf16_t* __restrict__ BT, int ldb, int K,
                                          f32x4 (&acc)[4][BN / 32], unsigned char* smem) {
  constexpr int TA = 128 * 128, TB = BN * 128, STAGE = TA + TB, GLB = BN / 32;
  const int tid = get_tid(), lane = tid & 63, wv = tid >> 6, g = lane >> 4, r16 = lane & 15;
  const int wm = wv >> 1, wn = wv & 1;
  int ga[4], gb[GLB];
#pragma unroll
  for (int i = 0; i < 4; ++i) { int R, C; stage_rc2(wv * 1024 + i * 4096 + lane * 16, R, C); ga[i] = R * lda + C; }
#pragma unroll
  for (int i = 0; i < GLB; ++i) { int R, C; stage_rc2(wv * 1024 + i * 4096 + lane * 16, R, C); gb[i] = R * ldb + C; }
  int offA[4], offB[GLB];
#pragma unroll
  for (int mi = 0; mi < 4; ++mi) offA[mi] = lds_byte2(wm * 64 + mi * 16 + r16, g * 8);
#pragma unroll
  for (int ni = 0; ni < GLB; ++ni) offB[ni] = TA + lds_byte2(wn * (BN / 2) + ni * 16 + r16, g * 8);
#define GT_STAGE(buf, koff) do { \
    _Pragma("unroll") for (int i = 0; i < 4; ++i) \
      __builtin_amdgcn_global_load_lds((const unsigned*)(A + ga[i] + (koff)), (unsigned*)(smem + (buf) * STAGE + wv * 1024 + i * 4096), 16, 0, 0); \
    _Pragma("unroll") for (int i = 0; i < GLB; ++i) \
      __builtin_amdgcn_global_load_lds((const unsigned*)(BT + gb[i] + (koff)), (unsigned*)(smem + (buf) * STAGE + TA + wv * 1024 + i * 4096), 16, 0, 0); \
  } while (0)
  const int nt = K / 64;
  GT_STAGE(0, 0);
  asm volatile("s_waitcnt vmcnt(0)" ::: "memory");
  __syncthreads();
  for (int t = 0; t < nt; ++t) {
    const int cur = t & 1;
    if (t + 1 < nt) GT_STAGE(cur ^ 1, (t + 1) * 64);
    const unsigned char* sb = smem + cur * STAGE;
#pragma unroll
    for (int kk = 0; kk < 2; ++kk) {
      bf16x8 a[4], b[GLB];
#pragma unroll
      for (int mi = 0; mi < 4; ++mi) a[mi] = *(const bf16x8*)(sb + offA[mi] + kk * 1024);
#pragma unroll
      for (int ni = 0; ni < GLB; ++ni) b[ni] = *(const bf16x8*)(sb + offB[ni] + kk * 1024);
#pragma unroll
      for (int mi = 0; mi < 4; ++mi)
#pragma unroll
        for (int ni = 0; ni < GLB; ++ni) acc[mi][ni] = mfma16(a[mi], b[ni], acc[mi][ni]);
    }
    asm volatile("s_waitcnt vmcnt(0)" ::: "memory");
    __syncthreads();
  }
#undef GT_STAGE
}

__device__ __forceinline__ void phaseB(const Params& P, int l, unsigned char* smem) {
  const int tid = get_tid(), lane = tid & 63, wv = tid >> 6, g = lane >> 4, r16 = lane & 15;
  const int wm = wv >> 1, wn = wv & 1;
  const int ntiles = 136 * 61;
  for (int t = blockIdx.x; t < ntiles; t += gridDim.x) {
    const int nt = t / 136, mt = t % 136;
    const int m0 = mt * 128, n0 = nt * 128;
    f32x4 acc[4][4];
#pragma unroll
    for (int i = 0; i < 4; ++i)
#pragma unroll
      for (int j = 0; j < 4; ++j) acc[i][j] = (f32x4){0.f, 0.f, 0.f, 0.f};
    gemm_tile<128>(P.u + (size_t)m0 * DM, DM, WINT(l) + (size_t)n0 * DM, DM, DM, acc, smem);
    if (nt < 42) {
      bf16_t* sm = (bf16_t*)(smem + wv * 9216);
#pragma unroll
      for (int mi = 0; mi < 4; ++mi)
#pragma unroll
        for (int ni = 0; ni < 4; ++ni)
#pragma unroll
          for (int r = 0; r < 4; ++r) sm[(mi * 16 + 4 * g + r) * 72 + ni * 16 + r16] = f2bf(acc[mi][ni][r]);
      asm volatile("s_waitcnt lgkmcnt(0)" ::: "memory");
      bf16_t* gp = P.p + (size_t)(m0 + wm * 64) * PS + n0 + wn * 64 + (lane & 7) * 8;
#pragma unroll
      for (int itr = 0; itr < 8; ++itr) {
        const int row = itr * 8 + (lane >> 3);
        uint4 v = *(const uint4*)(sm + row * 72 + (lane & 7) * 8);
        *(uint4*)(gp + (size_t)row * PS) = v;
      }
      __syncthreads();
      continue;
    }
#pragma unroll
    for (int ni = 0; ni < 4; ++ni) {
      const int colb = n0 + wn * 64 + ni * 16;
      const int col = colb + r16;
#pragma unroll
      for (int mi = 0; mi < 4; ++mi) {
        const int rowb = m0 + wm * 64 + mi * 16 + 4 * g;
        f32x4 a = acc[mi][ni];
        if (colb < C_HXV) {
#pragma unroll
          for (int r = 0; r < 4; ++r) P.p[(size_t)(rowb + r) * PS + col] = f2bf(a[r]);
        } else if (colb < C_GV) {
          uint2 o; o.x = pk2(a[0], a[1]); o.y = pk2(a[2], a[3]);
          *(uint2*)(P.xvT + (size_t)(col - C_HXV) * NTOK + rowb) = o;
        } else if (colb < C_AB) {
          int b, key;
          if (rowb < NLAT) { b = rowb >> 12; key = 256 + (rowb & 4095); } else { b = (rowb - NLAT) >> 8; key = (rowb - NLAT) & 255; }
          uint2 o; o.x = pk2(a[0], a[1]); o.y = pk2(a[2], a[3]);
          if (colb < C_DV) { int cv = col - C_GV; int kvh = cv >> 7, d = cv & 127;
            *(uint2*)(P.gvT + ((size_t)(b * 2 + kvh) * 128 + d) * NKEY + key) = o;
          } else { int cv = col - C_DV; int h = cv >> 7, d = cv & 127;
            *(uint2*)(P.dvT + ((size_t)(b * 4 + h) * 128 + d) * NKEY + key) = o; }
        } else if (colb < C_MERGE) {
#pragma unroll
          for (int r = 0; r < 4; ++r) P.ab[(size_t)(rowb + r) * 16 + (col - C_AB)] = a[r];
        }
      }
    }
  }
}

__device__ __forceinline__ void attnprep_rows(const Params& P, int l, int row_begin, int row_end, int row_step) {
  const int tid = get_tid(); const int wv = tid >> 6, lane = tid & 63;
  const float* qn = P.gqa_qn + l * 128; const float* kn = P.gqa_kn + l * 128;
  const float LOG2E = 1.4426950408889634f;
  for (int row = row_begin + wv; row < row_end; row += row_step) {
    const bool isctx = row >= NLAT;
    float cg_ = 1.f, sg_ = 0.f, cd_ = 1.f, sd_ = 0.f;
    if (!isctx) {
      int t = row & 4095; float rp = (float)(t >> 6), cp = (float)(t & 63);
      { int pi = lane; float pos = (pi < 32) ? rp : cp; int j = pi & 31;
        float inv = exp2f(-(float)j * (13.287712379549449f / 32.f)); sincosf(pos * inv, &sg_, &cg_); }
      { int pi = lane & 31; float pos = (pi < 16) ? rp : cp; int j = pi & 15;
        float inv = exp2f(-(float)j * (13.287712379549449f / 16.f)); sincosf(pos * inv, &sd_, &cd_); }
    }
    bf16_t* pr = P.p + (size_t)row * PS;
    uint32_t* pg[6]; uint32_t wg[6]; uint32_t* pd[8]; uint32_t wd[8];
#pragma unroll
    for (int hh = 0; hh < 6; ++hh) { pg[hh] = (uint32_t*)(pr + ((hh < 4) ? C_GQ + hh * 128 : C_GK + (hh - 4) * 128)) + lane; wg[hh] = *pg[hh]; }
#pragma unroll
    for (int it = 0; it < 8; ++it) { int unit = (it & 3) * 2 + (lane >> 5);
      pd[it] = (uint32_t*)(pr + ((it < 4) ? C_DQ : C_DK) + unit * 64) + (lane & 31); wd[it] = *pd[it]; }
    const float qn0 = qn[2 * lane], qn1 = qn[2 * lane + 1], kn0 = kn[2 * lane], kn1 = kn[2 * lane + 1];
#pragma unroll
    for (int hh = 0; hh < 6; ++hh) {
      const bool isq = hh < 4;
      float x1 = lo2f(wg[hh]), x2 = hi2f(wg[hh]);
      float ms = wsum(x1 * x1 + x2 * x2, lane) * (1.f / 128.f);
      float rs = rsqrtf(ms + EPSV);
      x1 = x1 * rs * (isq ? qn0 : kn0); x2 = x2 * rs * (isq ? qn1 : kn1);
      float y1 = x1 * cg_ - x2 * sg_, y2 = x1 * sg_ + x2 * cg_;
      if (isq) { const float sc = 0.08838834764831845f * LOG2E; y1 *= sc; y2 *= sc; }
      wg[hh] = pk2(y1, y2);
    }
#pragma unroll
    for (int it = 0; it < 8; ++it) {
      const bool isq = it < 4;
      float x1 = lo2f(wd[it]), x2 = hi2f(wd[it]);
      float y1 = x1 * cd_ - x2 * sd_, y2 = x1 * sd_ + x2 * cd_;
      if (isq) { const float sc = 0.125f * LOG2E; y1 *= sc; y2 *= sc; }
      wd[it] = pk2(y1, y2);
    }
#pragma unroll
    for (int hh = 0; hh < 6; ++hh) *pg[hh] = wg[hh];
#pragma unroll
    for (int it = 0; it < 8; ++it) *pd[it] = wd[it];
  }
}

__device__ __forceinline__ void gdnprep_item(const Params& P, int l, int it, unsigned char* smem) {
  bf16_t* kb = (bf16_t*)smem;
  bf16_t* vb = kb + 64 * 136;
  bf16_t* qb = vb + 64 * 136;
  float* T = (float*)qb;
  float* T1 = (float*)(smem + 3 * 64 * 136 * 2);
  float* sc_cum = (float*)(smem + 3 * 64 * 136 * 2 + 16384);
  float* sc_beta = sc_cum + 128;
  float* sc_cw = sc_beta + 128;
  const int tid = get_tid(), lane = tid & 63, wv = tid >> 6, g = lane >> 4, r16 = lane & 15;
  const int ci = it >> 2, hd = it & 3;
  const int r0 = ci * 64;
  int seq0, seqn;
  if (ci < 256) { seq0 = (ci >> 6) * 4096; seqn = 4096; } else { seq0 = NLAT + ((ci - 256) >> 2) * 256; seqn = 256; }
  const float* cwt = P.gdn_conv + (size_t)l * 4 * 1536;
  __syncthreads();
#pragma unroll 3
  for (int itr = 0; itr < 12; ++itr) {
    int e = tid + 256 * itr;
    int cc = e & 15, tp = e >> 4; int tk = tp & 63, part = tp >> 6;
    int colb = part * 512 + hd * 128 + cc * 8;
    int row = r0 + tk;
    float acc[8];
#pragma unroll
    for (int j = 0; j < 8; ++j) acc[j] = 0.f;
#pragma unroll
    for (int tap = 0; tap < 4; ++tap) {
      int rr = row - 1 + tap;
      if (rr >= seq0 && rr < seq0 + seqn) {
        U128 xv; xv.u = *(const uint4*)(P.p + (size_t)rr * PS + C_GQKV + colb);
        float4 w0 = *(const float4*)(cwt + tap * 1536 + colb);
        float4 w1 = *(const float4*)(cwt + tap * 1536 + colb + 4);
        acc[0] += lo2f(xv.w[0]) * w0.x; acc[1] += hi2f(xv.w[0]) * w0.y; acc[2] += lo2f(xv.w[1]) * w0.z; acc[3] += hi2f(xv.w[1]) * w0.w;
        acc[4] += lo2f(xv.w[2]) * w1.x; acc[5] += hi2f(xv.w[2]) * w1.y; acc[6] += lo2f(xv.w[3]) * w1.z; acc[7] += hi2f(xv.w[3]) * w1.w;
      }
    }
    float ss = 0.f;
#pragma unroll
    for (int j = 0; j < 8; ++j) { acc[j] = siluf(acc[j]); ss += acc[j] * acc[j]; }
    ss += shx(ss, lane, 1); ss += shx(ss, lane, 2); ss += shx(ss, lane, 4); ss += shx(ss, lane, 8);
    float scl = 1.f;
    if (part == 0) scl = rsqrtf(ss + EPSV) * 0.08838834764831845f;
    else if (part == 1) scl = rsqrtf(ss + EPSV);
    U128 o;
#pragma unroll
    for (int j = 0; j < 4; ++j) o.w[j] = pk2(acc[2 * j] * scl, acc[2 * j + 1] * scl);
    bf16_t* dstb = (part == 0) ? qb : (part == 1 ? kb : vb);
    *(uint4*)(dstb + tk * 136 + cc * 8) = o.u;
  }
  if (tid < 128) {
    int dir = wv, i = lane; int tk = dir ? 63 - i : i; int row = r0 + tk;
    float a = P.ab[(size_t)row * 16 + dir * 4 + hd];
    float bb = P.ab[(size_t)row * 16 + 8 + dir * 4 + hd];
    float xx = a + P.gdn_dt_bias[l * 8 + dir * 4 + hd];
    float sp = (xx > 20.f) ? xx : log1pf(expf(xx));
    float gg = -expf(P.gdn_a_log[l * 8 + dir * 4 + hd]) * sp;
    float beta = 1.f / (1.f + expf(-bb));
    float cum = gg;
#pragma unroll
    for (int o = 1; o < 64; o <<= 1) { float t = __int_as_float(__builtin_amdgcn_ds_bpermute(((lane >= o) ? lane - o : lane) << 2, __float_as_int(cum))); if (lane >= o) cum += t; }
    sc_cum[dir * 64 + i] = cum; sc_beta[dir * 64 + i] = beta; sc_cw[dir * 64 + i] = beta * expf(cum);
  }
  __syncthreads();
  f32x4 akk[4], aqk[4];
#pragma unroll
  for (int j = 0; j < 4; ++j) { akk[j] = (f32x4){0.f, 0.f, 0.f, 0.f}; aqk[j] = (f32x4){0.f, 0.f, 0.f, 0.f}; }
#pragma unroll
  for (int ks = 0; ks < 4; ++ks) {
    bf16x8 ak = *(const bf16x8*)(kb + (wv * 16 + r16) * 136 + ks * 32 + g * 8);
    bf16x8 aq = *(const bf16x8*)(qb + (wv * 16 + r16) * 136 + ks * 32 + g * 8);
#pragma unroll
    for (int jt = 0; jt < 4; ++jt) {
      bf16x8 b = *(const bf16x8*)(kb + (jt * 16 + r16) * 136 + ks * 32 + g * 8);
      akk[jt] = mfma16(ak, b, akk[jt]); aqk[jt] = mfma16(aq, b, aqk[jt]);
    }
  }
  const size_t rec0 = ((size_t)ci * 4 + hd) * 2;
#pragma unroll
  for (int jt = 0; jt < 4; ++jt) {
    int j = jt * 16 + r16;
#pragma unroll
    for (int r = 0; r < 4; ++r) {
      int i = wv * 16 + 4 * g + r;
      float qk = aqk[jt][r];
      float v0 = (j <= i) ? qk * __expf(sc_cum[i] - sc_cum[j]) : 0.f;
      P.gQK[(rec0 + 0) * 4096 + i * 64 + j] = f2bf(v0);
      int i1 = 63 - i, j1 = 63 - j;
      float v1 = (j1 <= i1) ? qk * __expf(sc_cum[64 + i1] - sc_cum[64 + j1]) : 0.f;
      P.gQK[(rec0 + 1) * 4096 + i1 * 64 + j1] = f2bf(v1);
    }
  }
#pragma unroll 1
  for (int dir = 0; dir < 2; ++dir) {
    const float cl = sc_cum[dir * 64 + 63];
#pragma unroll
    for (int itr = 0; itr < 4; ++itr) {
      int e = tid + 256 * itr; int i = e >> 4, cc = e & 15; int tk = dir ? 63 - i : i;
      float sc = __expf(sc_cum[dir * 64 + i]);
      U128 xv; xv.u = *(const uint4*)(qb + tk * 136 + cc * 8);
      U128 o;
#pragma unroll
      for (int j = 0; j < 4; ++j) o.w[j] = pk2(lo2f(xv.w[j]) * sc, hi2f(xv.w[j]) * sc);
      *(uint4*)(P.gQd + (rec0 + dir) * 8192 + i * 128 + cc * 8) = o.u;
    }
#pragma unroll
    for (int itr = 0; itr < 4; ++itr) {
      int e = tid + 256 * itr; int d = e >> 3, ic = e & 7;
      float vv[8];
#pragma unroll
      for (int j = 0; j < 8; ++j) { int i = ic * 8 + j; int tk = dir ? 63 - i : i;
        vv[j] = bf2f(kb[tk * 136 + d]) * __expf(cl - sc_cum[dir * 64 + i]); }
      U128 o;
#pragma unroll
      for (int j = 0; j < 4; ++j) o.w[j] = pk2(vv[2 * j], vv[2 * j + 1]);
      *(uint4*)(P.gKtT + (rec0 + dir) * 8192 + d * 64 + ic * 8) = o.u;
    }
    if (tid == 0) P.gGl[rec0 + dir] = __expf(cl);
  }
  __syncthreads();
#pragma unroll
  for (int jt = 0; jt < 4; ++jt) {
    int j = jt * 16 + r16;
#pragma unroll
    for (int r = 0; r < 4; ++r) {
      int i = wv * 16 + 4 * g + r;
      if (j < i) T[i * 64 + j] = sc_beta[i] * akk[jt][r] * __expf(sc_cum[i] - sc_cum[j]);
      int ii = 63 - i, jj = 63 - j;
      if (jj < ii) T1[ii * 64 + jj] = sc_beta[64 + ii] * akk[jt][r] * __expf(sc_cum[64 + ii] - sc_cum[64 + jj]);
    }
  }
  __syncthreads();
  {
    const int col = tid;
    const bool isw = col < 128;
    const bf16_t* srcb = isw ? (kb + col) : (vb + (col - 128));
    const float* coef0 = isw ? sc_cw : sc_beta;
    const float* coef1 = coef0 + 64;
    float x[64], y[64];
#pragma unroll
    for (int i = 0; i < 64; ++i) {
      float a0 = bf2f(srcb[i * 136]) * coef0[i], a1 = 0.f, a2 = 0.f, a3 = 0.f;
      float b0 = bf2f(srcb[(63 - i) * 136]) * coef1[i], b1 = 0.f, b2 = 0.f, b3 = 0.f;
#pragma unroll
      for (int j4 = 0; j4 < (i + 3) / 4; ++j4) {
        float4 t4 = *(const float4*)(T + i * 64 + j4 * 4);
        float4 u4 = *(const float4*)(T1 + i * 64 + j4 * 4);
        if (j4 * 4 + 0 < i) { a0 -= t4.x * x[j4 * 4 + 0]; b0 -= u4.x * y[j4 * 4 + 0]; }
        if (j4 * 4 + 1 < i) { a1 -= t4.y * x[j4 * 4 + 1]; b1 -= u4.y * y[j4 * 4 + 1]; }
        if (j4 * 4 + 2 < i) { a2 -= t4.z * x[j4 * 4 + 2]; b2 -= u4.z * y[j4 * 4 + 2]; }
        if (j4 * 4 + 3 < i) { a3 -= t4.w * x[j4 * 4 + 3]; b3 -= u4.w * y[j4 * 4 + 3]; }
      }
      x[i] = (a0 + a1) + (a2 + a3);
      y[i] = (b0 + b1) + (b2 + b3);
    }
    if (isw) {
      bf16_t* d0 = P.gW + (rec0 + 0) * 8192 + col;
      bf16_t* d1 = P.gW + (rec0 + 1) * 8192 + col;
#pragma unroll
      for (int i = 0; i < 64; ++i) { d0[i * 128] = f2bf(x[i]); d1[i * 128] = f2bf(y[i]); }
    } else {
      uint4* d0 = (uint4*)(P.gUT + (rec0 + 0) * 8192 + (col - 128) * 64);
      uint4* d1 = (uint4*)(P.gUT + (rec0 + 1) * 8192 + (col - 128) * 64);
#pragma unroll
      for (int c8 = 0; c8 < 8; ++c8) {
        U128 o, o1;
#pragma unroll
        for (int j = 0; j < 4; ++j) { o.w[j] = pk2(x[c8 * 8 + 2 * j], x[c8 * 8 + 2 * j + 1]); o1.w[j] = pk2(y[c8 * 8 + 2 * j], y[c8 * 8 + 2 * j + 1]); }
        d0[c8] = o.u; d1[c8] = o1.u;
      }
    }
  }
  __syncthreads();
}

__device__ __forceinline__ void scan_item(const Params& P, int l, int it, unsigned char* smem) {
  bf16_t* ST0 = (bf16_t*)smem;
  bf16_t* ST1 = ST0 + 32 * 144;
  bf16_t* vnT = ST1 + 32 * 144;
  const int tid = get_tid(), lane = tid & 63, wv = tid >> 6, g = lane >> 4, r16 = lane & 15;
  const int sl = it & 3, dir = (it >> 2) & 1, hd = (it >> 3) & 3, b = it >> 5;
  __syncthreads();
  for (int e = tid; e < 32 * 144; e += 256) ST0[e] = 0;
  f32x4 S[2][2];
#pragma unroll
  for (int i = 0; i < 2; ++i)
#pragma unroll
    for (int j = 0; j < 2; ++j) S[i][j] = (f32x4){0.f, 0.f, 0.f, 0.f};
  bf16_t* cur = ST0; bf16_t* nxt = ST1;
  __syncthreads();
#define SCAN_CI(st) (((st) < 4) ? (256 + b * 4 + (dir ? 3 - (st) : (st))) : (b * 64 + (dir ? 63 - ((st) - 4) : ((st) - 4))))
#define SCAN_LOAD(PFX, st) do { \
    const int ci_ = SCAN_CI(st); const size_t rec_ = ((size_t)ci_ * 4 + hd) * 2 + dir; \
    const bf16_t* Wp_ = P.gW + rec_ * 8192 + (wv * 16 + r16) * 128 + g * 8; \
    const bf16_t* Qp_ = P.gQd + rec_ * 8192 + (wv * 16 + r16) * 128 + g * 8; \
    const bf16_t* Kp_ = P.gKtT + rec_ * 8192 + ((2 * wv) * 16 + r16) * 64 + g * 8; \
    const bf16_t* QKp_ = P.gQK + rec_ * 4096 + (wv * 16 + r16) * 64 + g * 8; \
    const bf16_t* Up_ = P.gUT + rec_ * 8192 + (sl * 32 + r16) * 64 + wv * 16 + 4 * g; \
    PFX##w0 = *(const bf16x8*)(Wp_); PFX##w1 = *(const bf16x8*)(Wp_ + 32); PFX##w2 = *(const bf16x8*)(Wp_ + 64); PFX##w3 = *(const bf16x8*)(Wp_ + 96); \
    PFX##q0 = *(const bf16x8*)(Qp_); PFX##q1 = *(const bf16x8*)(Qp_ + 32); PFX##q2 = *(const bf16x8*)(Qp_ + 64); PFX##q3 = *(const bf16x8*)(Qp_ + 96); \
    PFX##qk0 = *(const bf16x8*)(QKp_); PFX##qk1 = *(const bf16x8*)(QKp_ + 32); \
    PFX##k00 = *(const bf16x8*)(Kp_); PFX##k01 = *(const bf16x8*)(Kp_ + 32); \
    PFX##k10 = *(const bf16x8*)(Kp_ + 16 * 64); PFX##k11 = *(const bf16x8*)(Kp_ + 16 * 64 + 32); \
    PFX##u0 = *(const uint2*)(Up_); PFX##u1 = *(const uint2*)(Up_ + 16 * 64); \
    PFX##gl = P.gGl[rec_]; PFX##ci = ci_; } while (0)
  bf16x8 cw0, cw1, cw2, cw3, cq0, cq1, cq2, cq3, cqk0, cqk1, ck00, ck01, ck10, ck11; uint2 cu0, cu1; float cgl; int cci;
  bf16x8 nw0, nw1, nw2, nw3, nq0, nq1, nq2, nq3, nqk0, nqk1, nk00, nk01, nk10, nk11; uint2 nu0, nu1; float ngl; int nci;
  SCAN_LOAD(c, 0);
#pragma unroll 1
  for (int step = 0; step < 68; ++step) {
    const bool isctx = step < 4;
    const int ci = cci;
    const float gl = cgl;
    const bool wantout = !(isctx && l == 3);
    { const int sn = (step + 1 < 68) ? step + 1 : 67; SCAN_LOAD(n, sn); }
    f32x4 a1[2] = {(f32x4){0.f, 0.f, 0.f, 0.f}, (f32x4){0.f, 0.f, 0.f, 0.f}};
    f32x4 a2[2] = {(f32x4){0.f, 0.f, 0.f, 0.f}, (f32x4){0.f, 0.f, 0.f, 0.f}};
    {
      const bf16x8 awv[4] = {cw0, cw1, cw2, cw3};
      const bf16x8 aqv[4] = {cq0, cq1, cq2, cq3};
#pragma unroll
      for (int ks = 0; ks < 4; ++ks) {
#pragma unroll
        for (int nt = 0; nt < 2; ++nt) {
          bf16x8 bs = *(const bf16x8*)(cur + (nt * 16 + r16) * 144 + ks * 32 + g * 8);
          a1[nt] = mfma16(awv[ks], bs, a1[nt]);
          a2[nt] = mfma16(aqv[ks], bs, a2[nt]);
        }
      }
    }
    {
      const uint2 uu[2] = {cu0, cu1};
#pragma unroll
      for (int nt = 0; nt < 2; ++nt) {
        float v0 = lo2f(uu[nt].x) - a1[nt][0], v1 = hi2f(uu[nt].x) - a1[nt][1];
        float v2 = lo2f(uu[nt].y) - a1[nt][2], v3 = hi2f(uu[nt].y) - a1[nt][3];
        uint2 o; o.x = pk2(v0, v1); o.y = pk2(v2, v3);
        *(uint2*)(vnT + (nt * 16 + r16) * 80 + wv * 16 + 4 * g) = o;
      }
    }
    __syncthreads();
#pragma unroll
    for (int mt = 0; mt < 2; ++mt)
#pragma unroll
      for (int nt = 0; nt < 2; ++nt) S[mt][nt] = S[mt][nt] * gl;
    {
      const bf16x8 aqk[2] = {cqk0, cqk1};
      const bf16x8 akk[2][2] = {{ck00, ck01}, {ck10, ck11}};
#pragma unroll
      for (int ks = 0; ks < 2; ++ks) {
        bf16x8 bv[2];
#pragma unroll
        for (int nt = 0; nt < 2; ++nt) bv[nt] = *(const bf16x8*)(vnT + (nt * 16 + r16) * 80 + ks * 32 + g * 8);
#pragma unroll
        for (int nt = 0; nt < 2; ++nt) a2[nt] = mfma16(aqk[ks], bv[nt], a2[nt]);
#pragma unroll
        for (int mt = 0; mt < 2; ++mt)
#pragma unroll
          for (int nt = 0; nt < 2; ++nt) S[mt][nt] = mfma16(akk[mt][ks], bv[nt], S[mt][nt]);
      }
    }
    if (wantout) {
#pragma unroll
      for (int nt = 0; nt < 2; ++nt)
#pragma unroll
        for (int r = 0; r < 4; ++r) {
          int i = wv * 16 + 4 * g + r; int tok = ci * 64 + (dir ? 63 - i : i);
          P.ogdn[((size_t)dir * NTOK + tok) * 512 + hd * 128 + sl * 32 + nt * 16 + r16] = f2bf(a2[nt][r]);
        }
    }
#pragma unroll
    for (int mt = 0; mt < 2; ++mt)
#pragma unroll
      for (int nt = 0; nt < 2; ++nt) {
        uint2 o; o.x = pk2(S[mt][nt][0], S[mt][nt][1]); o.y = pk2(S[mt][nt][2], S[mt][nt][3]);
        *(uint2*)(nxt + (nt * 16 + r16) * 144 + (2 * wv + mt) * 16 + 4 * g) = o;
      }
    __syncthreads();
    bf16_t* t = cur; cur = nxt; nxt = t;
    cw0 = nw0; cw1 = nw1; cw2 = nw2; cw3 = nw3; cq0 = nq0; cq1 = nq1; cq2 = nq2; cq3 = nq3;
    cqk0 = nqk0; cqk1 = nqk1; ck00 = nk00; ck01 = nk01; ck10 = nk10; ck11 = nk11; cu0 = nu0; cu1 = nu1; cgl = ngl; cci = nci;
  }
#undef SCAN_LOAD
#undef SCAN_CI
}

template <int DQK>
__device__ __forceinline__ void attn_item(const bf16_t* __restrict__ qbase, const bf16_t* __restrict__ kbase,
                                          const bf16_t* __restrict__ vT, int b, int qrow0, int nkt,
                                          bf16_t* __restrict__ obase, int ldo, unsigned char* smem) {
  constexpr int KS = DQK / 32;
  constexpr int KROWB = DQK * 2;
  constexpr int KBYTES = 64 * KROWB;
  constexpr int STG = KBYTES + 16384;
  constexpr int RPI = 1024 / KROWB;
  constexpr int CPRK = KROWB / 16;
  const int tid = get_tid(), lane = tid & 63, wv = tid >> 6, g = lane >> 4, r16 = lane & 15;
  __syncthreads();
  bf16x8 qf[2][KS];
#pragma unroll
  for (int qt = 0; qt < 2; ++qt)
#pragma unroll
    for (int ks = 0; ks < KS; ++ks)
      qf[qt][ks] = *(const bf16x8*)(qbase + (size_t)(qrow0 + wv * 32 + qt * 16 + r16) * PS + ks * 32 + g * 8);
  int ksrc[KS], vsrc[4];
#pragma unroll
  for (int i = 0; i < KS; ++i) {
    const int row = RPI * (wv + 4 * i) + lane / CPRK, slot = lane % CPRK;
    const int c = (DQK == 128) ? (slot ^ (row & 15)) : (slot ^ ((row >> 1) & 7));
    ksrc[i] = row * PS + c * 8;
  }
#pragma unroll
  for (int i = 0; i < 4; ++i) {
    const int d = 8 * (wv + 4 * i) + (lane >> 3), slot = lane & 7;
    const int c = slot ^ ((d >> 1) & 7);
    vsrc[i] = d * NKEY + c * 8;
  }
  int koff[KS], voff[2][2];
#pragma unroll
  for (int ks = 0; ks < KS; ++ks)
    koff[ks] = r16 * KROWB + (((ks * 4 + g) ^ ((DQK == 128) ? r16 : (r16 >> 1))) * 16);
#pragma unroll
  for (int k2 = 0; k2 < 2; ++k2) {
    const int c0 = k2 * 4 + (g >> 1);
    voff[k2][0] = KBYTES + r16 * 128 + ((c0 ^ (r16 >> 1)) * 16) + (g & 1) * 8;
    voff[k2][1] = KBYTES + r16 * 128 + (((c0 + 2) ^ (r16 >> 1)) * 16) + (g & 1) * 8;
  }
#define AT_STAGE(buf, kt_) do { \
    const int kt__ = (kt_); \
    const int krow__ = (kt__ < 4) ? (NLAT + b * 256 + kt__ * 64) : (b * 4096 + (kt__ - 4) * 64); \
    const bf16_t* kg__ = kbase + (size_t)krow__ * PS; const bf16_t* vg__ = vT + kt__ * 64; \
    _Pragma("unroll") for (int i = 0; i < KS; ++i) \
      __builtin_amdgcn_global_load_lds((const unsigned*)(kg__ + ksrc[i]), (unsigned*)(smem + (buf) * STG + (wv + 4 * i) * 1024), 16, 0, 0); \
    _Pragma("unroll") for (int i = 0; i < 4; ++i) \
      __builtin_amdgcn_global_load_lds((const unsigned*)(vg__ + vsrc[i]), (unsigned*)(smem + (buf) * STG + KBYTES + (wv + 4 * i) * 1024), 16, 0, 0); \
  } while (0)
  f32x4 ao[8][2];
#pragma unroll
  for (int i = 0; i < 8; ++i) { ao[i][0] = (f32x4){0.f, 0.f, 0.f, 0.f}; ao[i][1] = (f32x4){0.f, 0.f, 0.f, 0.f}; }
  float mrun[2] = {0.f, 0.f};
  f32x4 accl[2] = {(f32x4){0.f, 0.f, 0.f, 0.f}, (f32x4){0.f, 0.f, 0.f, 0.f}};
  U128 ones; ones.w[0] = 0x3F803F80u; ones.w[1] = 0x3F803F80u; ones.w[2] = 0x3F803F80u; ones.w[3] = 0x3F803F80u;
  AT_STAGE(0, 0);
  asm volatile("s_waitcnt vmcnt(0)" ::: "memory");
  __syncthreads();
#pragma unroll 1
  for (int kt = 0; kt < nkt; ++kt) {
    const int cur = kt & 1;
    if (kt + 1 < nkt) AT_STAGE(cur ^ 1, kt + 1);
    const unsigned char* sb = smem + cur * STG;
    f32x4 sa[4][2];
    {
      const float n0 = -mrun[0], n1 = -mrun[1];
#pragma unroll
      for (int i = 0; i < 4; ++i) { sa[i][0] = (f32x4){n0, n0, n0, n0}; sa[i][1] = (f32x4){n1, n1, n1, n1}; }
    }
    bf16x8 kf[2][4];
#pragma unroll
    for (int mt = 0; mt < 4; ++mt) kf[0][mt] = *(const bf16x8*)(sb + mt * 16 * KROWB + koff[0]);
#pragma unroll
    for (int ks = 0; ks < KS; ++ks) {
      __builtin_amdgcn_sched_barrier(0);
      if (ks + 1 < KS) {
#pragma unroll
        for (int mt = 0; mt < 4; ++mt) kf[(ks + 1) & 1][mt] = *(const bf16x8*)(sb + mt * 16 * KROWB + koff[(ks + 1 < KS) ? ks + 1 : 0]);
      }
#pragma unroll
      for (int mt = 0; mt < 4; ++mt) {
        sa[mt][0] = mfma16(kf[ks & 1][mt], qf[0][ks], sa[mt][0]);
        sa[mt][1] = mfma16(kf[ks & 1][mt], qf[1][ks], sa[mt][1]);
      }
    }
    __builtin_amdgcn_sched_barrier(0);
    bf16x8 pf[2][2];
#pragma unroll
    for (int qt = 0; qt < 2; ++qt) {
      float mx = -1e30f;
#pragma unroll
      for (int mt = 0; mt < 4; ++mt)
#pragma unroll
        for (int r = 0; r < 4; ++r) mx = fmaxf(mx, sa[mt][qt][r]);
      if (kt == 0 || __any(mx > 6.f)) {
        mx = fmaxf(mx, shx(mx, lane, 16)); mx = fmaxf(mx, shx(mx, lane, 32));
        const float delta = (kt == 0) ? -mx : -fmaxf(mx, 0.f);
        const float alpha = (kt == 0) ? 1.f : __builtin_amdgcn_exp2f(delta); mrun[qt] -= delta;
        accl[qt] = accl[qt] * alpha;
#pragma unroll
        for (int dt = 0; dt < 8; ++dt) ao[dt][qt] = ao[dt][qt] * alpha;
#pragma unroll
        for (int mt = 0; mt < 4; ++mt) sa[mt][qt] = sa[mt][qt] + delta;
      }
#pragma unroll
      for (int mt = 0; mt < 4; ++mt)
#pragma unroll
        for (int r = 0; r < 4; ++r) sa[mt][qt][r] = __builtin_amdgcn_exp2f(sa[mt][qt][r]);
#pragma unroll
      for (int k2 = 0; k2 < 2; ++k2) {
        U128 pp;
        pp.w[0] = pk2(sa[2 * k2][qt][0], sa[2 * k2][qt][1]); pp.w[1] = pk2(sa[2 * k2][qt][2], sa[2 * k2][qt][3]);
        pp.w[2] = pk2(sa[2 * k2 + 1][qt][0], sa[2 * k2 + 1][qt][1]); pp.w[3] = pk2(sa[2 * k2 + 1][qt][2], sa[2 * k2 + 1][qt][3]);
        pf[qt][k2] = pp.v;
      }
    }
    U128 av[2][8];
#pragma unroll
    for (int dt = 0; dt < 8; ++dt) {
      uint2 v0 = *(const uint2*)(sb + dt * 2048 + voff[0][0]);
      uint2 v1 = *(const uint2*)(sb + dt * 2048 + voff[0][1]);
      av[0][dt].w[0] = v0.x; av[0][dt].w[1] = v0.y; av[0][dt].w[2] = v1.x; av[0][dt].w[3] = v1.y;
    }
    __builtin_amdgcn_sched_barrier(0);
#pragma unroll
    for (int dt = 0; dt < 8; ++dt) {
      uint2 v0 = *(const uint2*)(sb + dt * 2048 + voff[1][0]);
      uint2 v1 = *(const uint2*)(sb + dt * 2048 + voff[1][1]);
      av[1][dt].w[0] = v0.x; av[1][dt].w[1] = v0.y; av[1][dt].w[2] = v1.x; av[1][dt].w[3] = v1.y;
    }
#pragma unroll
    for (int dt = 0; dt < 8; ++dt) {
      ao[dt][0] = mfma16(av[0][dt].v, pf[0][0], ao[dt][0]);
      ao[dt][1] = mfma16(av[0][dt].v, pf[1][0], ao[dt][1]);
    }
    accl[0] = mfma16(ones.v, pf[0][0], accl[0]); accl[1] = mfma16(ones.v, pf[1][0], accl[1]);
    __builtin_amdgcn_sched_barrier(0);
#pragma unroll
    for (int dt = 0; dt < 8; ++dt) {
      ao[dt][0] = mfma16(av[1][dt].v, pf[0][1], ao[dt][0]);
      ao[dt][1] = mfma16(av[1][dt].v, pf[1][1], ao[dt][1]);
    }
    accl[0] = mfma16(ones.v, pf[0][1], accl[0]); accl[1] = mfma16(ones.v, pf[1][1], accl[1]);
    asm volatile("s_waitcnt vmcnt(0)" ::: "memory");
    __syncthreads();
  }
#undef AT_STAGE
#pragma unroll
  for (int qt = 0; qt < 2; ++qt) {
    const float lsum = accl[qt][0];
    float inv = 1.f / lsum;
    bf16_t* op = obase + (size_t)(qrow0 + wv * 32 + qt * 16 + r16) * ldo + 4 * g;
#pragma unroll
    for (int dt = 0; dt < 8; ++dt) {
      uint2 o; o.x = pk2(ao[dt][qt][0] * inv, ao[dt][qt][1] * inv); o.y = pk2(ao[dt][qt][2] * inv, ao[dt][qt][3] * inv);
      *(uint2*)(op + dt * 16) = o;
    }
  }
}

template <int NQ>
__device__ __forceinline__ void hyena_item(const Params& P, int l, int c, unsigned char* smem) {
  constexpr int n = NQ * 256;
  constexpr int RL = 2 * n + 256;
  constexpr int ZL = n + 256 + 16;
  bf16_t* R0 = (bf16_t*)smem; bf16_t* R1 = R0 + RL; bf16_t* Z = R1 + RL;
  const bf16_t* filt = (NQ == 16) ? FILTL(l) : FILTC(l);
  const int tid = get_tid(), lane = tid & 63, wv = tid >> 6, g = lane >> 4, r16 = lane & 15;
  const float* cw = P.hy_conv + (size_t)l * 3 * 1536;
  __syncthreads();
  for (int e = tid; e < 4 * 256; e += 256) { int bb = e >> 8, k = e & 255; Z[bb * ZL + (k < 128 ? k : n + k)] = 0; }
  {
    const float w0 = cw[1024 + c], w1 = cw[1536 + 1024 + c], w2 = cw[3072 + 1024 + c];
    const bf16_t* xr = P.xvT + (size_t)(1024 + c) * NTOK;
    for (int e = tid; e < 4 * (n / 8); e += 256) {
      int bb = e / (n / 8), t0 = (e % (n / 8)) * 8;
      int rb = (NQ == 16) ? bb * 4096 + t0 : NLAT + bb * 256 + t0;
      U128 xv; xv.u = *(const uint4*)(xr + rb);
      float xs[10];
      xs[0] = (t0 > 0) ? bf2f(xr[rb - 1]) : 0.f;
#pragma unroll
      for (int j = 0; j < 4; ++j) { xs[1 + 2 * j] = lo2f(xv.w[j]); xs[2 + 2 * j] = hi2f(xv.w[j]); }
      xs[9] = (t0 + 8 < n) ? bf2f(xr[rb + 8]) : 0.f;
      U128 o;
#pragma unroll
      for (int j = 0; j < 4; ++j) {
        float a = w0 * xs[2 * j] + w1 * xs[2 * j + 1] + w2 * xs[2 * j + 2];
        float bq = w0 * xs[2 * j + 1] + w1 * xs[2 * j + 2] + w2 * xs[2 * j + 3];
        o.w[j] = pk2(a, bq);
      }
      *(uint4*)(Z + bb * ZL + 128 + t0) = o.u;
    }
  }
  const int bb = r16 >> 2, mm = r16 & 3;
  f32x4 acc[NQ];
#pragma unroll 1
  for (int o = 0; o < 2; ++o) {
    {
      const bf16_t* src = filt + (size_t)(o * 512 + c) * (2 * n);
      for (int e = tid; e < RL / 8; e += 256) {
        int y0 = e * 8; U128 a; uint32_t nx = 0;
        if (y0 >= 128 && y0 < 128 + 2 * n) {
          a.u = *(const uint4*)(src + y0 - 128);
          if (y0 + 8 < 128 + 2 * n) nx = src[y0 - 120];
        } else { a.u = make_uint4(0, 0, 0, 0); if (y0 + 8 == 128) nx = src[0]; }
        *(uint4*)(R0 + y0) = a.u;
        U128 s;
        s.w[0] = (a.w[0] >> 16) | (a.w[1] << 16); s.w[1] = (a.w[1] >> 16) | (a.w[2] << 16);
        s.w[2] = (a.w[2] >> 16) | (a.w[3] << 16); s.w[3] = (a.w[3] >> 16) | (nx << 16);
        *(uint4*)(R1 + y0) = s.u;
      }
    }
    if (o == 1) {
#pragma unroll
      for (int qi = 0; qi < NQ; ++qi) {
        int q = wv * NQ + qi; int T0 = (q >> 1) * 128 + (q & 1) * 16; int t = T0 + 32 * mm + 4 * g;
        uint2 zz; zz.x = pk2(acc[qi][0], acc[qi][1]); zz.y = pk2(acc[qi][2], acc[qi][3]);
        *(uint2*)(Z + bb * ZL + 128 + t) = zz;
      }
    }
    __syncthreads();
#pragma unroll
    for (int qi = 0; qi < NQ; ++qi) acc[qi] = (f32x4){0.f, 0.f, 0.f, 0.f};
    {
      const int par = r16 & 1;
      const bf16_t* rbp = par ? R1 : R0;
      const uint32_t* rp = (const uint32_t*)(rbp + (n + 128 - r16 + 8 * g - par));
      const bf16_t* zp = Z + bb * ZL + 128 + 32 * mm + 8 * g;
      const uint32_t* rlow;
      if (NQ == 1) rlow = rp - ((wv >> 1) * 64 + (wv & 1) * 8);
      else rlow = rp - (((wv * NQ) >> 1) + (NQ / 2 - 1)) * 64 - 8;
      rlow += -3 * 16; zp += -3 * 32;
#define HY_OFF(qi) ((NQ == 1) ? 0 : ((NQ / 2 - 1 - ((qi) >> 1)) * 64 + (1 - ((qi) & 1)) * 8))
      if constexpr (NQ == 1) {
#pragma unroll 1
        for (int w = -3; w < n / 32; ++w) {
          bf16x8 bfr = *(const bf16x8*)(zp);
          U128 a0; a0.w[0] = rlow[0]; a0.w[1] = rlow[1]; a0.w[2] = rlow[2]; a0.w[3] = rlow[3];
          acc[0] = mfma16(a0.v, bfr, acc[0]);
          rlow += 16; zp += 32;
        }
      } else {
        const uint32_t* rb0 = rlow + 48 + 448;
        const bf16_t* z0 = zp + 96;
#define HY_LDG(dst, ptr) do { dst.w[0] = (ptr)[0]; dst.w[1] = (ptr)[1]; dst.w[2] = (ptr)[2]; dst.w[3] = (ptr)[3]; } while (0)
#pragma unroll 1
        for (int tau = -31; tau < -3; ++tau) {
          const uint32_t* ap = rb0 + 16 * tau;
          U128 g0, g1; HY_LDG(g0, ap + 8); HY_LDG(g1, ap);
#pragma unroll
          for (int d = 1; d < 8; ++d) {
            const int w = tau + 4 * d;
            if (w >= -3) {
              bf16x8 bfr = *(const bf16x8*)(z0 + 32 * w);
              acc[2 * d] = mfma16(g0.v, bfr, acc[2 * d]); acc[2 * d + 1] = mfma16(g1.v, bfr, acc[2 * d + 1]);
            }
          }
        }
        {
          U128 g0, g1, ng0, ng1; bf16x8 bA[4], bB[4];
          { const uint32_t* ap = rb0 + 16 * (-3); HY_LDG(g0, ap + 8); HY_LDG(g1, ap); }
#pragma unroll
          for (int d = 0; d < 4; ++d) bA[d] = *(const bf16x8*)(z0 + 32 * (-3 + 4 * d));
#pragma unroll 1
          for (int tau = -3; tau < 100; ++tau) {
            const bf16_t* zt = z0 + 32 * tau;
            __builtin_amdgcn_sched_barrier(0);
#pragma unroll
            for (int d = 0; d < 4; ++d) bB[d] = *(const bf16x8*)(zt + 32 * 4 * (d + 4));
#pragma unroll
            for (int d = 0; d < 4; ++d) { acc[2 * d] = mfma16(g0.v, bA[d], acc[2 * d]); acc[2 * d + 1] = mfma16(g1.v, bA[d], acc[2 * d + 1]); }
            __builtin_amdgcn_sched_barrier(0);
            { const uint32_t* ap = rb0 + 16 * (tau + 1); HY_LDG(ng0, ap + 8); HY_LDG(ng1, ap); }
#pragma unroll
            for (int d = 0; d < 4; ++d) bA[d] = *(const bf16x8*)(zt + 32 + 32 * 4 * d);
#pragma unroll
            for (int d = 0; d < 4; ++d) { acc[2 * (d + 4)] = mfma16(g0.v, bB[d], acc[2 * (d + 4)]); acc[2 * (d + 4) + 1] = mfma16(g1.v, bB[d], acc[2 * (d + 4) + 1]); }
            g0 = ng0; g1 = ng1;
          }
          __builtin_amdgcn_sched_barrier(0);
        }
#pragma unroll 1
        for (int tau = 100; tau < 128; ++tau) {
          const uint32_t* ap = rb0 + 16 * tau;
          U128 g0, g1; HY_LDG(g0, ap + 8); HY_LDG(g1, ap);
#pragma unroll
          for (int d = 0; d < 7; ++d) {
            const int w = tau + 4 * d;
            if (w <= 127) {
              bf16x8 bfr = *(const bf16x8*)(z0 + 32 * w);
              acc[2 * d] = mfma16(g0.v, bfr, acc[2 * d]); acc[2 * d + 1] = mfma16(g1.v, bfr, acc[2 * d + 1]);
            }
          }
        }
#undef HY_LDG
      }
#undef HY_OFF
    }
    int vz = 0; asm volatile("" : "+v"(vz));
    const int xch = (o == 0) ? c : 512 + c;
    const bf16_t* xr = P.xvT + (size_t)xch * NTOK;
    uint2 xq[NQ]; uint32_t xe[NQ];
    {
      const int q0 = wv * NQ; const int T00 = (q0 >> 1) * 128 + (q0 & 1) * 16;
      const int tb = T00 + 32 * mm + 4 * g + vz;
      const bf16_t* xb = xr + ((NQ == 16) ? bb * 4096 : NLAT + bb * 256) + tb;
#pragma unroll
      for (int qi = 0; qi < NQ; ++qi) {
        const int toff = (qi >> 1) * 128 + (qi & 1) * 16;
        const int t = tb + toff;
        xq[qi] = *(const uint2*)(xb + toff);
        uint32_t pv, nv;
        if (qi > 0) pv = (uint32_t)xb[toff - 1];
        else { pv = (uint32_t)xb[(t > 0) ? -1 : 0]; pv = (t > 0) ? pv : 0u; }
        if (qi + 1 < NQ) nv = (uint32_t)xb[toff + 4];
        else { nv = (uint32_t)xb[(t + 4 < n) ? toff + 4 : toff]; nv = (t + 4 < n) ? nv : 0u; }
        xe[qi] = pv | (nv << 16);
      }
    }
    __builtin_amdgcn_sched_barrier(0);
    const float bias = P.hy_bias[(l * 2 + o) * 512 + c];
    const float w0 = cw[xch], w1 = cw[1536 + xch], w2 = cw[3072 + xch];
#pragma unroll
    for (int qi = 0; qi < NQ; ++qi) {
      int q = wv * NQ + qi; int T0 = (q >> 1) * 128 + (q & 1) * 16; int t = T0 + 32 * mm + 4 * g + vz;
      U64 zv; zv.u = *(const uint2*)(Z + bb * ZL + 128 + t);
      int rb = (NQ == 16) ? bb * 4096 + t : NLAT + bb * 256 + t;
      float xs[6];
      xs[0] = lo2f(xe[qi]);
      xs[1] = lo2f(xq[qi].x); xs[2] = hi2f(xq[qi].x); xs[3] = lo2f(xq[qi].y); xs[4] = hi2f(xq[qi].y);
      xs[5] = hi2f(xe[qi]);
      float zf[4] = {lo2f(zv.w[0]), hi2f(zv.w[0]), lo2f(zv.w[1]), hi2f(zv.w[1])};
      float res[4];
#pragma unroll
      for (int r = 0; r < 4; ++r) {
        float yv = acc[qi][r] + zf[r] * bias;
        float xc = w0 * xs[r] + w1 * xs[r + 1] + w2 * xs[r + 2];
        res[r] = xc * yv;
      }
      if (o == 0) { acc[qi] = (f32x4){res[0], res[1], res[2], res[3]}; }
      else {
#pragma unroll
        for (int r = 0; r < 4; ++r) P.ybraw[(size_t)(rb + r) * 512 + c] = f2bf(res[r]);
      }
      __builtin_amdgcn_sched_barrier(0);
    }
    __syncthreads();
  }
}

__device__ __forceinline__ void phaseE0(const Params& P, int l) {
  const int tid = get_tid(); const int wv = tid >> 6, lane = tid & 63;
  const int nrows = (l == 3) ? NLAT : NTOK;
  const float lam_init = 0.8f - 0.6f * expf(-0.3f * (float)l);
  float lam;
  {
    const float* dl = P.diff_lam + l * 256;
    float s1 = wsum(dl[lane] * dl[64 + lane], lane);
    float s2 = wsum(dl[128 + lane] * dl[192 + lane], lane);
    lam = expf(s1) - expf(s2) + lam_init;
  }
  const int d0 = (lane & 15) * 8;
  float gnw[8], dnw[8];
#pragma unroll
  for (int j = 0; j < 8; ++j) { gnw[j] = P.gdn_norm[l * 128 + d0 + j]; dnw[j] = P.diff_norm[l * 128 + d0 + j]; }
  for (int row = blockIdx.x * 4 + wv; row < nrows; row += gridDim.x * 4) {
    const bf16_t* pr = P.p + (size_t)row * PS;
    bf16_t* yr = P.y + (size_t)row * 2048;
    const int h = lane >> 4;
    U128 af, ab_, ag, bf_, bg, cf, cgt, o1, o2, dg;
    af.u = *(const uint4*)(P.ogdn + (size_t)row * 512 + lane * 8);
    ab_.u = *(const uint4*)(P.ogdn + ((size_t)NTOK + row) * 512 + lane * 8);
    ag.u = *(const uint4*)(pr + C_GGATE + lane * 8);
    bf_.u = *(const uint4*)(P.ybraw + (size_t)row * 512 + lane * 8);
    bg.u = *(const uint4*)(pr + C_HGATE + lane * 8);
    cf.u = *(const uint4*)(P.gqao + (size_t)row * 512 + lane * 8);
    cgt.u = *(const uint4*)(pr + C_GGT + lane * 8);
    o1.u = *(const uint4*)(P.diffo + (size_t)row * 1024 + (2 * h) * 128 + d0);
    o2.u = *(const uint4*)(P.diffo + (size_t)row * 1024 + (2 * h + 1) * 128 + d0);
    dg.u = *(const uint4*)(pr + C_DGT + lane * 8);
    U128 ya, yb, yc, yd;
    {
      float o[8]; float ss = 0.f;
#pragma unroll
      for (int j = 0; j < 4; ++j) {
        o[2 * j] = lo2f(af.w[j]) + lo2f(ab_.w[j]); o[2 * j + 1] = hi2f(af.w[j]) + hi2f(ab_.w[j]);
        ss += o[2 * j] * o[2 * j] + o[2 * j + 1] * o[2 * j + 1];
      }
      ss += shx(ss, lane, 1); ss += shx(ss, lane, 2); ss += shx(ss, lane, 4); ss += shx(ss, lane, 8);
      float rs = rsqrtf(ss * (1.f / 128.f) + EPSV);
#pragma unroll
      for (int j = 0; j < 4; ++j)
        ya.w[j] = pk2(o[2 * j] * rs * gnw[2 * j] * siluf(lo2f(ag.w[j])), o[2 * j + 1] * rs * gnw[2 * j + 1] * siluf(hi2f(ag.w[j])));
    }
#pragma unroll
    for (int j = 0; j < 4; ++j) {
      yb.w[j] = pk2(lo2f(bf_.w[j]) * siluf(lo2f(bg.w[j])), hi2f(bf_.w[j]) * siluf(hi2f(bg.w[j])));
      yc.w[j] = pk2(lo2f(cf.w[j]) * siluf(lo2f(cgt.w[j])), hi2f(cf.w[j]) * siluf(hi2f(cgt.w[j])));
    }
    {
      float o[8]; float ss = 0.f;
#pragma unroll
      for (int j = 0; j < 4; ++j) {
        o[2 * j] = lo2f(o1.w[j]) - lam * lo2f(o2.w[j]); o[2 * j + 1] = hi2f(o1.w[j]) - lam * hi2f(o2.w[j]);
        ss += o[2 * j] * o[2 * j] + o[2 * j + 1] * o[2 * j + 1];
      }
      ss += shx(ss, lane, 1); ss += shx(ss, lane, 2); ss += shx(ss, lane, 4); ss += shx(ss, lane, 8);
      float rs = rsqrtf(ss * (1.f / 128.f) + EPSV) * (1.f - lam_init);
#pragma unroll
      for (int j = 0; j < 4; ++j)
        yd.w[j] = pk2(o[2 * j] * rs * dnw[2 * j] * siluf(lo2f(dg.w[j])), o[2 * j + 1] * rs * dnw[2 * j + 1] * siluf(hi2f(dg.w[j])));
    }
    *(uint4*)(yr + lane * 8) = ya.u;
    *(uint4*)(yr + 512 + lane * 8) = yb.u;
    *(uint4*)(yr + 1024 + lane * 8) = yc.u;
    *(uint4*)(yr + 1536 + lane * 8) = yd.u;
  }
}

__device__ __forceinline__ void phaseE1(const Params& P, int l, unsigned char* smem) {
  const int tid = get_tid(), lane = tid & 63, wv = tid >> 6, g = lane >> 4, r16 = lane & 15;
  const int wm = wv >> 1, wn = wv & 1;
  const int mtiles = (l == 3) ? 128 : 136;
  const int ntiles = mtiles * 16;
  for (int t = blockIdx.x; t < ntiles; t += gridDim.x) {
    const int nt = t / mtiles, mt = t % mtiles;
    const int m0 = mt * 128, n0 = nt * 64;
    f32x4 tot[4][2];
#pragma unroll
    for (int i = 0; i < 4; ++i) { tot[i][0] = (f32x4){0.f, 0.f, 0.f, 0.f}; tot[i][1] = (f32x4){0.f, 0.f, 0.f, 0.f}; }
#pragma unroll 1
    for (int br = 0; br < 4; ++br) {
      f32x4 ag[4][2], ap[4][2];
#pragma unroll
      for (int i = 0; i < 4; ++i) { ag[i][0] = (f32x4){0.f, 0.f, 0.f, 0.f}; ag[i][1] = ag[i][0]; ap[i][0] = ag[i][0]; ap[i][1] = ag[i][0]; }
      gemm_tile<64>(P.u + (size_t)m0 * DM, DM, WINT(l) + (size_t)(C_MERGE + br * 1024 + n0) * DM, DM, DM, ag, smem);
      gemm_tile<64>(P.y + (size_t)m0 * 2048 + br * 512, 2048, WBRT(l) + ((size_t)br * 1024 + n0) * 512, 512, 512, ap, smem);
#pragma unroll
      for (int i = 0; i < 4; ++i)
#pragma unroll
        for (int j = 0; j < 2; ++j)
#pragma unroll
          for (int r = 0; r < 4; ++r) tot[i][j][r] += sigmf(ag[i][j][r]) * ap[i][j][r];
    }
    {
      bf16_t* sm = (bf16_t*)(smem + wv * 5120);
#pragma unroll
      for (int mi = 0; mi < 4; ++mi)
#pragma unroll
        for (int ni = 0; ni < 2; ++ni)
#pragma unroll
          for (int r = 0; r < 4; ++r) sm[(mi * 16 + 4 * g + r) * 40 + ni * 16 + r16] = f2bf(tot[mi][ni][r]);
      asm volatile("s_waitcnt lgkmcnt(0)" ::: "memory");
      bf16_t* gp = P.s + (size_t)(m0 + wm * 64) * DM + n0 + wn * 32 + (lane & 3) * 8;
#pragma unroll
      for (int itr = 0; itr < 4; ++itr) {
        const int row = itr * 16 + (lane >> 2);
        uint4 v = *(const uint4*)(sm + row * 40 + (lane & 3) * 8);
        *(uint4*)(gp + (size_t)row * DM) = v;
      }
      __syncthreads();
    }
  }
}
__device__ __forceinline__ void phaseE2(const Params& P, int l, unsigned char* smem) {
  const int tid = get_tid(), lane = tid & 63, wv = tid >> 6, g = lane >> 4, r16 = lane & 15;
  const int wm = wv >> 1, wn = wv & 1;
  const int mtiles = (l == 3) ? 128 : 136;
  const int ntiles = mtiles * 16;
  for (int t = blockIdx.x; t < ntiles; t += gridDim.x) {
    const int nt = t / mtiles, mt = t % mtiles;
    const int m0 = mt * 128, n0 = nt * 64;
    f32x4 acc[4][2];
#pragma unroll
    for (int i = 0; i < 4; ++i) { acc[i][0] = (f32x4){0.f, 0.f, 0.f, 0.f}; acc[i][1] = (f32x4){0.f, 0.f, 0.f, 0.f}; }
    gemm_tile<64>(P.s + (size_t)m0 * DM, DM, WOUTT(l) + (size_t)n0 * DM, DM, DM, acc, smem);
    {
      float* sm = (float*)(smem + wv * 9216);
#pragma unroll
      for (int mi = 0; mi < 4; ++mi)
#pragma unroll
        for (int ni = 0; ni < 2; ++ni)
#pragma unroll
          for (int r = 0; r < 4; ++r) sm[(mi * 16 + 4 * g + r) * 36 + ni * 16 + r16] = acc[mi][ni][r];
      asm volatile("s_waitcnt lgkmcnt(0)" ::: "memory");
      float* gp = P.outf + (size_t)(m0 + wm * 64) * DM + n0 + wn * 32 + (lane & 7) * 4;
#pragma unroll
      for (int itr = 0; itr < 8; ++itr) {
        const int row = itr * 8 + (lane >> 3);
        float4 v = *(const float4*)(sm + row * 36 + (lane & 7) * 4);
        *(float4*)(gp + (size_t)row * DM) = v;
      }
      __syncthreads();
    }
  }
}

__device__ __forceinline__ void phaseD(const Params& P, int l, unsigned char* smem, unsigned xcd, unsigned* cbase) {
  int* slot = (int*)(smem + SMEM_BYTES - 16);
  const int n_scan = 16, n_hl = 64, n_gl = 64, n_dl = 128;
  const int n_hc = (l < 3) ? 64 : 0, n_gc = (l < 3) ? 4 : 0, n_dc = (l < 3) ? 8 : 0;
  const int n_main = n_scan + n_hl + n_gl + n_dl + n_hc + n_gc + n_dc;
  const int total = n_main;
#pragma unroll 1
  for (int rr = 0; rr < 8; ++rr) {
    const int x = (int)((xcd + rr) & 7u);
    unsigned* qctr = cbase + l * 8 + x;
    while (true) {
      __syncthreads();
      if (threadIdx.x == 0) *slot = (int)atomicAdd(qctr, 1u);
      __syncthreads();
      int it = *slot;
      if (it >= total) break;
      if (it >= n_main) {
        const int j = it - n_main;
        if (j < 34) CALL_FILT(filt_item(P, l + 1, x * 34 + j, smem)); else convert_item(P, l + 1, x * 466 + (j - 34), smem);
        continue;
      }
      if (it < n_scan) { CALL_SCAN(scan_item(P, l, x * 16 + it, smem)); continue; }
      it -= n_scan;
      if (it < n_hl) { CALL_HY(hyena_item<16>(P, l, x * 64 + it, smem)); continue; }
      it -= n_hl;
      if (it < n_gl) {
        const int b = x >> 1, kvh = x & 1, h = kvh * 2 + (it >> 5), qb = it & 31;
        CALL_ATT(attn_item<128>(P.p + C_GQ + h * 128, P.p + C_GK + kvh * 128, P.gvT + (size_t)(b * 2 + kvh) * 128 * NKEY, b,
                       b * 4096 + qb * 128, 68, P.gqao + h * 128, 512, smem));
        continue;
      }
      it -= n_gl;
      if (it < n_dl) {
        const int grp = 2 * x + (it >> 6), b = grp >> 2, h = grp & 3, un = 2 * h + ((it >> 5) & 1), qb = it & 31;
        CALL_ATT(attn_item<64>(P.p + C_DQ + un * 64, P.p + C_DK + un * 64, P.dvT + (size_t)(b * 4 + h) * 128 * NKEY, b,
                      b * 4096 + qb * 128, 68, P.diffo + un * 128, 1024, smem));
        continue;
      }
      it -= n_dl;
      if (it < n_hc) { CALL_HY(hyena_item<1>(P, l, x * 64 + it, smem)); continue; }
      it -= n_hc;
      if (it < n_gc) {
        const int b = x >> 1, kvh = x & 1, h = kvh * 2 + (it >> 1), qb = it & 1;
        CALL_ATT(attn_item<128>(P.p + C_GQ + h * 128, P.p + C_GK + kvh * 128, P.gvT + (size_t)(b * 2 + kvh) * 128 * NKEY, b,
                       NLAT + b * 256 + qb * 128, 4, P.gqao + h * 128, 512, smem));
        continue;
      }
      it -= n_gc;
      {
        const int grp = 2 * x + (it >> 2), b = grp >> 2, h = grp & 3, un = 2 * h + ((it >> 1) & 1), qb = it & 1;
        CALL_ATT(attn_item<64>(P.p + C_DQ + un * 64, P.p + C_DK + un * 64, P.dvT + (size_t)(b * 4 + h) * 128 * NKEY, b,
                      NLAT + b * 256 + qb * 128, 4, P.diffo + un * 128, 1024, smem));
      }
    }
  }
}

#define XB_TMO      128
#define XB_XCNT(j)  (256  + 64 * (j))
#define XB_XSUB(j)  (1280 + 64 * (j))
#define XB_XGEN(j)  (2304 + 64 * (j))
#define XB_TOP      3328
#define XB_TOPGEN   3392
#define XCD_BAR_WORDS 3456
#define XB_SPIN_CAP (1u << 22)
#define LAS __attribute__((address_space(3)))
__device__ __forceinline__ unsigned xb_ld(unsigned* p)              { return __hip_atomic_load(p, __ATOMIC_RELAXED, __HIP_MEMORY_SCOPE_AGENT); }
__device__ __forceinline__ unsigned xb_add(unsigned* p, unsigned v) { return __hip_atomic_fetch_add(p, v, __ATOMIC_RELAXED, __HIP_MEMORY_SCOPE_AGENT); }
__device__ __forceinline__ unsigned xb_xcc_id() { return (unsigned)__builtin_amdgcn_s_getreg((3 << 11) | 20) & 0xFu; }
#define XB_SPIN(cond, bar) do { unsigned _sp = 0; while (cond) { __builtin_amdgcn_s_sleep(1); \
    if ((++_sp & 255u) == 0u) { if (xb_ld(&(bar)[XB_TMO])) break; if (_sp > XB_SPIN_CAP) { atomicAdd(&(bar)[XB_TMO], 1u); break; } } } } while (0)
struct XcdBarrier { unsigned* bar; unsigned x; volatile LAS unsigned* st; };
__device__ __forceinline__ XcdBarrier xcd_barrier_post(unsigned* bar, volatile LAS unsigned* st) {
  XcdBarrier b; b.bar = bar; b.x = xb_xcc_id(); b.st = st;
  if (threadIdx.x == 0) (void)xb_add(&bar[XB_XCNT(b.x)], 1u);
  return b;
}
__device__ __forceinline__ void xcd_barrier_complete(unsigned* bar, unsigned x, unsigned& nloc, unsigned& nx) {
  const unsigned G = gridDim.x * gridDim.y * gridDim.z;
  unsigned sum, cnt, mine, sp = 0u;
  for (;;) {
    sum = 0u; cnt = 0u; mine = 0u;
#pragma unroll
    for (unsigned j = 0; j < 16; ++j) { const unsigned c = xb_ld(&bar[XB_XCNT(j)]); sum += c; cnt += (c > 0u) ? 1u : 0u; mine = (j == x) ? c : mine; }
    if (sum == G) break;
    __builtin_amdgcn_s_sleep(1);
    if ((++sp & 255u) == 0u) { if (xb_ld(&bar[XB_TMO])) break; if (sp > XB_SPIN_CAP) { atomicAdd(&bar[XB_TMO], 1u); break; } }
  }
  nloc = mine > 0u ? mine : 1u; nx = cnt > 0u ? cnt : 1u;
}
__device__ __forceinline__ void xcd_barrier(const XcdBarrier& b) {
  asm volatile("s_waitcnt vmcnt(0)" ::: "memory");
  __syncthreads();
  if (threadIdx.x == 0) {
    unsigned* bar = b.bar;
    __builtin_amdgcn_s_waitcnt(0);
    unsigned nloc = b.st[0], nx = b.st[1];
    if (nloc == 0u) { xcd_barrier_complete(bar, b.x, nloc, nx); b.st[0] = nloc; b.st[1] = nx; }
    const unsigned old = xb_add(&bar[XB_XSUB(b.x)], 1u);
    const unsigned gen = old / nloc;
    if (old + 1u == (gen + 1u) * nloc) {
      __builtin_amdgcn_fence(__ATOMIC_RELEASE, "agent");
      asm volatile("s_waitcnt vmcnt(0)" ::: "memory");
      const unsigned og = xb_add(&bar[XB_TOP], 1u);
      const unsigned tg = og / nx;
      if (og + 1u == (tg + 1u) * nx) xb_add(&bar[XB_TOPGEN], 1u);
      else XB_SPIN(xb_ld(&bar[XB_TOPGEN]) == tg, bar);
      __builtin_amdgcn_fence(__ATOMIC_ACQUIRE, "agent");
      xb_add(&bar[XB_XGEN(b.x)], 1u);
      asm volatile("s_waitcnt vmcnt(0)" ::: "memory");
    } else {
      XB_SPIN(xb_ld(&bar[XB_XGEN(b.x)]) == gen, bar);
      __builtin_amdgcn_fence(__ATOMIC_ACQUIRE, "agent");
      asm volatile("s_waitcnt vmcnt(0)" ::: "memory");
    }
  }
  __syncthreads();
}

__global__ void __launch_bounds__(256, 2) fwd_megakernel(Params P) {
  __shared__ __attribute__((aligned(16))) unsigned char smem[SMEM_BYTES];
  cg::grid_group grid = cg::this_grid();
  if (threadIdx.x < 2) ((volatile unsigned*)(smem + SMEM_BYTES - 32))[threadIdx.x] = 0u;
  __syncthreads();
  XcdBarrier xb = xcd_barrier_post(P.xbar, (volatile LAS unsigned*)(smem + SMEM_BYTES - 32));
  for (int it = blockIdx.x; it < 192; it += gridDim.x) mod_item(P, it, smem);
  if (P.out == nullptr) grid.sync();
  xcd_barrier(xb);
#pragma unroll 1
  for (int l = 0; l < 4; ++l) {
    phase_rows(P, l);
    if (gridDim.x == 512) {
      if (blockIdx.x < 272) { CALL_FILT(filt_item(P, l, blockIdx.x, smem)); }
      else for (int j = blockIdx.x - 272; j < 932; j += 240) convert4_item(P, l, j, smem);
    } else {
      for (int it = blockIdx.x; it < 3728 + 272; it += gridDim.x) {
        if (it < 272) { CALL_FILT(filt_item(P, l, it, smem)); } else convert_item(P, l, it - 272, smem);
      }
    }
    xcd_barrier(xb);
    CALL_B(phaseB(P, l, smem));
#ifdef PROBE_G2
    xcd_barrier(xb);
    phaseB(P, l, smem);
#endif
    xcd_barrier(xb);
    {
      int* slot = (int*)(smem + SMEM_BYTES - 16);
      unsigned* qc = P.ctr + 32 + l;
      while (true) {
        __syncthreads();
        if (threadIdx.x == 0) *slot = (int)atomicAdd(qc, 1u);
        __syncthreads();
        const int it = *slot;
        if (it >= 1088 + 544) break;
        if (it < 1088) { CALL_PREP(gdnprep_item(P, l, it, smem)); }
        else { const int r0 = (it - 1088) * 32; attnprep_rows(P, l, r0, r0 + 32, 4); }
      }
    }
    xcd_barrier(xb);
    phaseD(P, l, smem, xb.x, P.ctr);
#ifdef PROBE_D2
    xcd_barrier(xb);
    phaseD(P, l, smem, xb.x, P.ctr + 64);
#endif
    xcd_barrier(xb);
    phaseE0(P, l);
#ifdef PROBE_E02
    xcd_barrier(xb);
    phaseE0(P, l);
#endif
    xcd_barrier(xb);
    CALL_E1(phaseE1(P, l, smem));
#ifdef PROBE_G2
    xcd_barrier(xb);
    phaseE1(P, l, smem);
#endif
    xcd_barrier(xb);
    phaseE2(P, l, smem);
#ifdef PROBE_G2
    xcd_barrier(xb);
    phaseE2(P, l, smem);
#endif
    xcd_barrier(xb);
  }
  phase_rows(P, 4);
}

extern "C" void kernel_launch(void* const* d_in, const int* in_sizes, int n_in, void* d_out, int out_size, void* d_ws,
                              size_t ws_size, hipStream_t stream) {
  static int grid_blocks = 0;
  if (!grid_blocks) {
    int dev = 0, cus = 0, per_cu = 0;
    (void)hipGetDevice(&dev);
    (void)hipDeviceGetAttribute(&cus, hipDeviceAttributeMultiprocessorCount, dev);
    (void)hipOccupancyMaxActiveBlocksPerMultiprocessor(&per_cu, fwd_megakernel, 256, 0);
    if (per_cu > 2) per_cu = 2;
    if (per_cu < 1) per_cu = 1;
    grid_blocks = cus * per_cu;
  }
  Params P;
  memset(&P, 0, sizeof(P));
  const float** pin = (const float**)&P;
  for (int i = 0; i < 29; ++i) pin[i] = (const float*)d_in[i];
  P.out = (float*)d_out;
  size_t off = 0;
  auto take = [&](size_t bytes) { void* r = (char*)d_ws + off; off += (bytes + 255) & ~(size_t)255; return r; };
  P.ctr = (unsigned*)take(1024);
  P.xbar = (unsigned*)take(16384);
  P.mod = (float*)take((size_t)4 * 5 * 3072 * 4);
  P.hctx = (float*)take((size_t)NCTX * DM * 4);
  P.winT = (bf16_t*)take((size_t)2 * NIN * DM * 2);
  P.wbrT = (bf16_t*)take((size_t)2 * 4 * 1024 * 512 * 2);
  P.woutT = (bf16_t*)take((size_t)2 * 1024 * 1024 * 2);
  P.filtL = (bf16_t*)take((size_t)2 * 2 * 512 * 8192 * 2);
  P.filtC = (bf16_t*)take((size_t)2 * 2 * 512 * 512 * 2);
  P.u = (bf16_t*)take((size_t)NTOK * DM * 2);
  P.p = (bf16_t*)take((size_t)NTOK * PS * 2);
  P.xvT = (bf16_t*)take((size_t)1536 * NTOK * 2);
  P.gvT = (bf16_t*)take((size_t)4 * 2 * 128 * NKEY * 2);
  P.dvT = (bf16_t*)take((size_t)4 * 4 * 128 * NKEY * 2);
  P.ab = (float*)take((size_t)NTOK * 16 * 4);
  const size_t nrec = (size_t)272 * 4 * 2;
  char* gdn_base = (char*)d_ws + off;
  P.gW = (bf16_t*)take(nrec * 8192 * 2);
  P.gQd = (bf16_t*)take(nrec * 8192 * 2);
  P.gKtT = (bf16_t*)take(nrec * 8192 * 2);
  P.gQK = (bf16_t*)take(nrec * 4096 * 2);
  P.gUT = (bf16_t*)take(nrec * 8192 * 2);
  P.gGl = (float*)take(nrec * 4);
  P.ogdn = (bf16_t*)take((size_t)2 * NTOK * 512 * 2);
  P.ybraw = (bf16_t*)take((size_t)NTOK * 512 * 2);
  P.gqao = (bf16_t*)take((size_t)NTOK * 512 * 2);
  P.diffo = (bf16_t*)take((size_t)NTOK * 1024 * 2);
  P.y = (bf16_t*)gdn_base;
  P.outf = (float*)(gdn_base + (size_t)80 * 1024 * 1024);
  P.s = P.xvT;
  (void)hipMemsetAsync(P.ctr, 0, 1024 + 16384, stream);
  void* args[] = {&P};
  hipError_t e = hipLaunchCooperativeKernel((void*)fwd_megakernel, dim3(grid_blocks), dim3(256), args, 0, stream);
  if (e != hipSuccess) fprintf(stderr, "cooperative launch failed: %s (grid %d)\n", hipGetErrorString(e), grid_blocks);
}
```

```cpp
#include <hip/hip_runtime.h>
#include <hip/hip_cooperative_groups.h>
#include <stdint.h>
#include <stdio.h>
#include <string.h>
namespace cg = cooperative_groups;

#ifdef SK_SCAN
#define CALL_SCAN(x)
#else
#define CALL_SCAN(x) x
#endif
#ifdef SK_HY
#define CALL_HY(x)
#else
#define CALL_HY(x) x
#endif
#ifdef SK_PREP
#define CALL_PREP(x)
#else
#define CALL_PREP(x) x
#endif
#ifdef SK_FILT
#define CALL_FILT(x)
#else
#define CALL_FILT(x) x
#endif
#ifdef SK_E1
#define CALL_E1(x)
#else
#define CALL_E1(x) x
#endif
#ifdef SK_B
#define CALL_B(x)
#else
#define CALL_B(x) x
#endif
#ifdef SK_ATT
#define CALL_ATT(x)
#else
#define CALL_ATT(x) x
#endif

typedef unsigned short bf16_t;
typedef __attribute__((ext_vector_type(8))) short bf16x8;
typedef __attribute__((ext_vector_type(4))) float f32x4;

#define NLAT 16384
#define NCTX 1024
#define NTOK 17408
#define DM 1024
#define PS 5376
#define NKEY 4352
#define NIN 11792
#define SMEM_BYTES 71680
#define EPSV 1e-6f
#define ALPHA_DN 1.681792830507429f

#define C_GQKV 0
#define C_GGATE 1536
#define C_HGATE 2048
#define C_GQ 2560
#define C_GK 3072
#define C_GGT 3328
#define C_DQ 3840
#define C_DK 4352
#define C_DGT 4864
#define C_HXV 5376
#define C_GV 6912
#define C_DV 7168
#define C_AB 7680
#define C_MERGE 7696


#ifdef PROBE_HY2
#undef CALL_HY
#define CALL_HY(x) do { x; x; } while (0)
#endif
#ifdef PROBE_ATT2
#undef CALL_ATT
#define CALL_ATT(x) do { x; x; } while (0)
#endif
#ifdef PROBE_SCAN2
#undef CALL_SCAN
#define CALL_SCAN(x) do { x; x; } while (0)
#endif

union U128 { uint4 u; bf16x8 v; uint32_t w[4]; bf16_t h[8]; };
union U64 { uint2 u; uint32_t w[2]; bf16_t h[4]; };

typedef __bf16 hbf16x2_t __attribute__((ext_vector_type(2)));
typedef float hf32x2_t __attribute__((ext_vector_type(2)));
__device__ __forceinline__ uint32_t pk2(float a, float b) {
  hf32x2_t f = {a, b};
  hbf16x2_t h = __builtin_convertvector(f, hbf16x2_t);
  return __builtin_bit_cast(uint32_t, h);
}
__device__ __forceinline__ bf16_t f2bf(float f) { return (bf16_t)(pk2(f, 0.f) & 0xffffu); }
__device__ __forceinline__ float bf2f(bf16_t h) { return __uint_as_float(((unsigned)h) << 16); }
__device__ __forceinline__ float lo2f(uint32_t w) { return __uint_as_float(w << 16); }
__device__ __forceinline__ float hi2f(uint32_t w) { return __uint_as_float(w & 0xffff0000u); }
__device__ __forceinline__ f32x4 mfma16(bf16x8 a, bf16x8 b, f32x4 c) {
  return __builtin_amdgcn_mfma_f32_16x16x32_bf16(a, b, c, 0, 0, 0);
}
__device__ __forceinline__ float siluf(float x) { return x / (1.f + __expf(-x)); }
__device__ __forceinline__ float sigmf(float x) { return 1.f / (1.f + __expf(-x)); }
__device__ __forceinline__ float shx(float v, int lane, int o) {
  return __int_as_float(__builtin_amdgcn_ds_bpermute((lane ^ o) << 2, __float_as_int(v)));
}
__device__ __forceinline__ float wsum(float v, int lane) {
#pragma unroll
  for (int o = 32; o >= 1; o >>= 1) v += shx(v, lane, o);
  return v;
}

__device__ __forceinline__ int get_tid() { int t = threadIdx.x; asm volatile("" : "+v"(t)); return t; }

struct Params {
  const float *x, *c, *ctx, *c_ctx, *w_ada, *b_ada, *w_in, *gdn_conv, *gdn_a_log, *gdn_dt_bias, *gdn_norm,
      *hy_conv, *hy_w1, *hy_b1, *hy_w2, *hy_b2, *hy_w3, *hy_b3, *hy_w4, *hy_freq, *hy_bias,
      *gqa_qn, *gqa_kn, *diff_lam, *diff_norm, *w_br, *w_out, *ln_g, *ln_b;
  float* out;
  float* mod; float* hctx; bf16_t* winT; bf16_t* wbrT; bf16_t* woutT; bf16_t* filtL; bf16_t* filtC;
  bf16_t* u; bf16_t* p; bf16_t* xvT; bf16_t* gvT; bf16_t* dvT; float* ab;
  bf16_t *gW, *gQd, *gKtT, *gQK, *gUT; float* gGl;
  bf16_t* ogdn; bf16_t* ybraw; bf16_t* gqao; bf16_t* diffo;
  bf16_t* y; bf16_t* s; float* outf;
  unsigned* ctr; unsigned* xbar;
};

#define WINT(l) (P.winT + (size_t)((l) & 1) * NIN * DM)
#define WBRT(l) (P.wbrT + (size_t)((l) & 1) * 4 * 1024 * 512)
#define WOUTT(l) (P.woutT + (size_t)((l) & 1) * 1024 * 1024)
#define FILTL(l) (P.filtL + (size_t)((l) & 1) * 2 * 512 * 8192)
#define FILTC(l) (P.filtC + (size_t)((l) & 1) * 2 * 512 * 512)

__device__ __forceinline__ int win_orig_col(int n) {
  if (n < 1536) return n;
  if (n < 2048) return n - 1536 + 1552;
  if (n < 2560) return n - 2048 + 3600;
  if (n < 3072) return n - 2560 + 4112;
  if (n < 3328) return n - 3072 + 4624;
  if (n < 3840) return n - 3328 + 5136;
  if (n < 4352) return n - 3840 + 5648;
  if (n < 4864) return n - 4352 + 6160;
  if (n < 5376) return n - 4864 + 7184;
  if (n < 6912) return n - 5376 + 2064;
  if (n < 7168) return n - 6912 + 4880;
  if (n < 7680) return n - 7168 + 6672;
  if (n < 7696) return n - 7680 + 1536;
  return n;
}

__device__ __forceinline__ void mod_item(const Params& P, int it, unsigned char* smem) {
  float* sc = (float*)smem;
  float* red = sc + 5 * 1024;
  const int tid = get_tid(), lane = tid & 63, wv = tid >> 6;
  const int l = it / 48, cb = it % 48;
  __syncthreads();
  for (int e = tid; e < 5 * 1024; e += 256) {
    int v = e >> 10, k = e & 1023;
    float cv = (v < 4) ? P.c[v * 1024 + k] : P.c_ctx[k];
    sc[e] = siluf(cv);
  }
  __syncthreads();
  const float* w = P.w_ada + (size_t)l * 1024 * 3072 + cb * 64 + lane;
  float acc[5] = {0.f, 0.f, 0.f, 0.f, 0.f};
#pragma unroll 16
  for (int k = wv * 256; k < wv * 256 + 256; ++k) {
    float wv_ = w[(size_t)k * 3072];
#pragma unroll
    for (int v = 0; v < 5; ++v) acc[v] += sc[v * 1024 + k] * wv_;
  }
#pragma unroll
  for (int v = 0; v < 5; ++v) red[(wv * 5 + v) * 64 + lane] = acc[v];
  __syncthreads();
  for (int e = tid; e < 320; e += 256) {
    int v = e >> 6, j = e & 63;
    float s = red[(0 * 5 + v) * 64 + j] + red[(1 * 5 + v) * 64 + j] + red[(2 * 5 + v) * 64 + j] + red[(3 * 5 + v) * 64 + j];
    int col = cb * 64 + j;
    P.mod[((size_t)l * 5 + v) * 3072 + col] = s + P.b_ada[l * 3072 + col];
  }
}

__device__ __forceinline__ void convert_item(const Params& P, int l, int it, unsigned char* smem) {
  float* tile = (float*)smem;
  const int tid = get_tid();
  const float* src; bf16_t* dst; int Nsrc, K, N, nt, kt; bool mapc = false;
  if (it < 2960) { nt = it >> 4; kt = it & 15; src = P.w_in + (size_t)l * 1024 * NIN; Nsrc = NIN; K = 1024; N = NIN; dst = WINT(l); mapc = true; }
  else if (it < 2960 + 512) { int r = it - 2960; int br = r >> 7; r &= 127; nt = r >> 3; kt = r & 7;
    src = P.w_br + ((size_t)(l * 4 + br) * 512) * 1024; Nsrc = 1024; K = 512; N = 1024; dst = WBRT(l) + (size_t)br * 1024 * 512; }
  else { int r = it - 3472; nt = r >> 4; kt = r & 15; src = P.w_out + (size_t)l * 1024 * 1024; Nsrc = 1024; K = 1024; N = 1024; dst = WOUTT(l); }
  const int n0 = nt * 64, k0 = kt * 64;
  __syncthreads();
  {
    int n = tid & 63; int nn = n0 + n;
    int col = (nn < N) ? (mapc ? win_orig_col(nn) : nn) : -1;
#pragma unroll 4
    for (int i = 0; i < 16; ++i) {
      int k = i * 4 + (tid >> 6);
      tile[k * 65 + n] = (col >= 0) ? src[(size_t)(k0 + k) * Nsrc + col] : 0.f;
    }
  }
  __syncthreads();
  {
    int nl = tid >> 2, kc = (tid & 3) * 16;
    if (n0 + nl < N) {
      U128 a, b;
#pragma unroll
      for (int j = 0; j < 4; ++j) {
        a.w[j] = pk2(tile[(kc + 2 * j) * 65 + nl], tile[(kc + 2 * j + 1) * 65 + nl]);
        b.w[j] = pk2(tile[(kc + 8 + 2 * j) * 65 + nl], tile[(kc + 9 + 2 * j) * 65 + nl]);
      }
      uint4* d = (uint4*)(dst + (size_t)(n0 + nl) * K + k0 + kc);
      d[0] = a.u; d[1] = b.u;
    }
  }
}

__device__ __forceinline__ void convert4_item(const Params& P, int l, int it, unsigned char* smem) {
  float* tile = (float*)smem;
  const int tid = get_tid();
  const float* src; bf16_t* dst; int Nsrc, K, N, nt, kq; bool mapc = false;
  if (it < 740) { nt = it >> 2; kq = it & 3; src = P.w_in + (size_t)l * 1024 * NIN; Nsrc = NIN; K = 1024; N = NIN; dst = WINT(l); mapc = true; }
  else if (it < 740 + 128) { int r = it - 740; int br = r >> 5; r &= 31; nt = r >> 1; kq = r & 1;
    src = P.w_br + ((size_t)(l * 4 + br) * 512) * 1024; Nsrc = 1024; K = 512; N = 1024; dst = WBRT(l) + (size_t)br * 1024 * 512; }
  else { int r = it - 868; nt = r >> 2; kq = r & 3; src = P.w_out + (size_t)l * 1024 * 1024; Nsrc = 1024; K = 1024; N = 1024; dst = WOUTT(l); }
  const int n0 = nt * 64, k0 = kq * 256;
  __syncthreads();
  {
    const int n = tid & 63; const int nn = n0 + n;
    const int col = (nn < N) ? (mapc ? win_orig_col(nn) : nn) : -1;
    const float* sp = src + (size_t)(k0 + (tid >> 6)) * Nsrc + (col >= 0 ? col : 0);
    float* tp = tile + (tid >> 6) * 65 + n;
#pragma unroll 16
    for (int i = 0; i < 64; ++i) {
      float v = sp[(size_t)(i * 4) * Nsrc];
      tp[i * 4 * 65] = (col >= 0) ? v : 0.f;
    }
  }
  __syncthreads();
  {
    const int nl = tid >> 2, kc = (tid & 3) * 64;
    if (n0 + nl < N) {
      uint4* d = (uint4*)(dst + (size_t)(n0 + nl) * K + k0 + kc);
#pragma unroll
      for (int c8 = 0; c8 < 8; ++c8) {
        U128 a;
#pragma unroll
        for (int j = 0; j < 4; ++j)
          a.w[j] = pk2(tile[(kc + c8 * 8 + 2 * j) * 65 + nl], tile[(kc + c8 * 8 + 2 * j + 1) * 65 + nl]);
        d[c8] = a.u;
      }
    }
  }
}

__device__ __forceinline__ void filt_item(const Params& P, int l, int it, unsigned char* smem) {
  float* z = (float*)smem;
  float* ha = z + 528;
  float* hb = ha + 1024;
  const int tid = get_tid();
  int n, pos0; bf16_t* dst;
  if (it < 256) { n = 4096; pos0 = it * 16; dst = FILTL(l); } else { n = 256; pos0 = (it - 256) * 16; dst = FILTC(l); }
  const float* w1 = P.hy_w1 + l * 33 * 64; const float* b1 = P.hy_b1 + l * 64;
  const float* w2 = P.hy_w2 + l * 64 * 64; const float* b2 = P.hy_b2 + l * 64;
  const float* w3 = P.hy_w3 + l * 64 * 64; const float* b3 = P.hy_b3 + l * 64;
  const float* w4 = P.hy_w4 + (size_t)l * 64 * 2048; const float* fr = P.hy_freq + l * 64;
  __syncthreads();
  for (int e = tid; e < 16 * 33; e += 256) {
    int p = e / 33, j = e % 33; float pos = (float)(pos0 + p); float val;
    if (j == 0) val = pos / (float)(n - 1);
    else {
      int jj = (j - 1) & 15;
      float f = 1e-4f + (float)jj * ((15.f - 1e-4f) / 15.f);
      float ang = ((2.0f * 3.14159265358979323846f / (float)n) * pos) * f;
      val = (j <= 16) ? cosf(ang) : -sinf(ang);
    }
    z[e] = val;
  }
  __syncthreads();
  for (int e = tid; e < 1024; e += 256) {
    int p = e >> 6, m = e & 63; float a = b1[m];
    for (int j = 0; j < 33; ++j) a += z[p * 33 + j] * w1[j * 64 + m];
    ha[e] = sinf(fr[m] * a);
  }
  __syncthreads();
  for (int e = tid; e < 1024; e += 256) {
    int p = e >> 6, m = e & 63; float a = b2[m];
    for (int j = 0; j < 64; ++j) a += ha[p * 64 + j] * w2[j * 64 + m];
    hb[e] = sinf(fr[m] * a);
  }
  __syncthreads();
  for (int e = tid; e < 1024; e += 256) {
    int p = e >> 6, m = e & 63; float a = b3[m];
    for (int j = 0; j < 64; ++j) a += hb[p * 64 + j] * w3[j * 64 + m];
    ha[e] = sinf(fr[m] * a);
  }
  __syncthreads();
  const float dmin = -3.0701134573253945f, dmax = -15.350567286626973f;
  {
    float* wst = (float*)smem + 4096;
    const int p = tid >> 4, cs = tid & 15;
    const int lr = tid >> 5, lc = (tid & 31) * 4;
    const float* wsrc = w4 + (size_t)lr * 2048 + lc;
    float* wdst = wst + lr * 128 + lc;
#define FL_LD(i, g_) *(const float4*)(wsrc + (size_t)(8 * (i)) * 2048 + (g_) * 128)
    float4 pre0 = FL_LD(0, 0), pre1 = FL_LD(1, 0), pre2 = FL_LD(2, 0), pre3 = FL_LD(3, 0),
           pre4 = FL_LD(4, 0), pre5 = FL_LD(5, 0), pre6 = FL_LD(6, 0), pre7 = FL_LD(7, 0);
    const int pos = pos0 + p; const float t = (float)pos / (float)(n - 1);
#pragma unroll 1
    for (int grp = 0; grp < 16; ++grp) {
      __syncthreads();
      *(float4*)(wdst) = pre0; *(float4*)(wdst + 8 * 128) = pre1; *(float4*)(wdst + 16 * 128) = pre2; *(float4*)(wdst + 24 * 128) = pre3;
      *(float4*)(wdst + 32 * 128) = pre4; *(float4*)(wdst + 40 * 128) = pre5; *(float4*)(wdst + 48 * 128) = pre6; *(float4*)(wdst + 56 * 128) = pre7;
      __syncthreads();
      {
        const int gn = (grp + 1 < 16) ? grp + 1 : 15;
        pre0 = FL_LD(0, gn); pre1 = FL_LD(1, gn); pre2 = FL_LD(2, gn); pre3 = FL_LD(3, gn);
        pre4 = FL_LD(4, gn); pre5 = FL_LD(5, gn); pre6 = FL_LD(6, gn); pre7 = FL_LD(7, gn);
      }
      float acc[8];
#pragma unroll
      for (int j = 0; j < 8; ++j) acc[j] = 0.f;
#pragma unroll 8
      for (int m = 0; m < 64; ++m) {
        const float h = ha[p * 64 + m];
        const float4 wa = *(const float4*)(wst + m * 128 + cs * 8);
        const float4 wb = *(const float4*)(wst + m * 128 + cs * 8 + 4);
        acc[0] += h * wa.x; acc[1] += h * wa.y; acc[2] += h * wa.z; acc[3] += h * wa.w;
        acc[4] += h * wb.x; acc[5] += h * wb.y; acc[6] += h * wb.z; acc[7] += h * wb.w;
      }
#pragma unroll
      for (int j = 0; j < 8; ++j) {
        const int col = grp * 128 + cs * 8 + j;
        const int o = col >> 10, d = (col >> 9) & 1, c = col & 511;
        const float delta = -(dmin + (float)c * ((dmax - dmin) / 511.f));
        bf16_t* dd = dst + (size_t)(o * 512 + c) * (2 * n);
        const float val = acc[j] * __expf(-t * delta);
        if (d == 0) dd[n - pos] = f2bf(val);
        else { if (pos == 0) dd[0] = 0; else dd[n + pos] = f2bf(val); }
      }
    }
#undef FL_LD
  }
}

__device__ __forceinline__ void phase_rows(const Params& P, int l) {
  const int tid = get_tid(); const int wv = tid >> 6, lane = tid & 63;
  const int nrows = (l == 4) ? NLAT : NTOK;
  for (int row = blockIdx.x * 4 + wv; row < nrows; row += gridDim.x * 4) {
    const bool isctx = row >= NLAT;
    const int mi = isctx ? 4 : (row >> 12);
    float v[16];
    const float* src;
    if (l <= 1) src = isctx ? P.ctx + (size_t)(row - NLAT) * DM : P.x + (size_t)row * DM;
    else src = isctx ? P.hctx + (size_t)(row - NLAT) * DM : P.out + (size_t)row * DM;
#pragma unroll
    for (int j = 0; j < 4; ++j) {
      float4 t = *(const float4*)(src + j * 256 + lane * 4);
      v[4 * j] = t.x; v[4 * j + 1] = t.y; v[4 * j + 2] = t.z; v[4 * j + 3] = t.w;
    }
    if (l > 0) {
      const float* o = P.outf + (size_t)row * DM;
      const float* gate = P.mod + ((size_t)(l - 1) * 5 + mi) * 3072 + 2048;
      float sm = 0.f;
#pragma unroll
      for (int j = 0; j < 4; ++j) {
        float4 ov = *(const float4*)(o + j * 256 + lane * 4);
        float4 gv = *(const float4*)(gate + j * 256 + lane * 4);
        v[4 * j] = ALPHA_DN * v[4 * j] + gv.x * ov.x; v[4 * j + 1] = ALPHA_DN * v[4 * j + 1] + gv.y * ov.y;
        v[4 * j + 2] = ALPHA_DN * v[4 * j + 2] + gv.z * ov.z; v[4 * j + 3] = ALPHA_DN * v[4 * j + 3] + gv.w * ov.w;
        sm += v[4 * j] + v[4 * j + 1] + v[4 * j + 2] + v[4 * j + 3];
      }
      float mean = wsum(sm, lane) * (1.f / 1024.f);
      float sq = 0.f;
#pragma unroll
      for (int j = 0; j < 16; ++j) { float d = v[j] - mean; sq += d * d; }
      float rstd = rsqrtf(wsum(sq, lane) * (1.f / 1024.f) + EPSV);
      float* dstp = isctx ? P.hctx + (size_t)(row - NLAT) * DM : P.out + (size_t)row * DM;
      const float* lg = P.ln_g + (l - 1) * 1024; const float* lb = P.ln_b + (l - 1) * 1024;
#pragma unroll
      for (int j = 0; j < 4; ++j) {
        float4 g4 = *(const float4*)(lg + j * 256 + lane * 4);
        float4 b4 = *(const float4*)(lb + j * 256 + lane * 4);
        v[4 * j] = (v[4 * j] - mean) * rstd * g4.x + b4.x; v[4 * j + 1] = (v[4 * j + 1] - mean) * rstd * g4.y + b4.y;
        v[4 * j + 2] = (v[4 * j + 2] - mean) * rstd * g4.z + b4.z; v[4 * j + 3] = (v[4 * j + 3] - mean) * rstd * g4.w + b4.w;
        float4 t; t.x = v[4 * j]; t.y = v[4 * j + 1]; t.z = v[4 * j + 2]; t.w = v[4 * j + 3];
        *(float4*)(dstp + j * 256 + lane * 4) = t;
      }
    }
    if (l < 4) {
      float sm = 0.f;
#pragma unroll
      for (int j = 0; j < 16; ++j) sm += v[j];
      float mean = wsum(sm, lane) * (1.f / 1024.f);
      float sq = 0.f;
#pragma unroll
      for (int j = 0; j < 16; ++j) { float d = v[j] - mean; sq += d * d; }
      float rstd = rsqrtf(wsum(sq, lane) * (1.f / 1024.f) + EPSV);
      const float* md = P.mod + ((size_t)l * 5 + mi) * 3072;
#pragma unroll
      for (int j = 0; j < 4; ++j) {
        float4 sh = *(const float4*)(md + j * 256 + lane * 4);
        float4 scl = *(const float4*)(md + 1024 + j * 256 + lane * 4);
        float a0 = (v[4 * j] - mean) * rstd * (1.f + scl.x) + sh.x;
        float a1 = (v[4 * j + 1] - mean) * rstd * (1.f + scl.y) + sh.y;
        float a2 = (v[4 * j + 2] - mean) * rstd * (1.f + scl.z) + sh.z;
        float a3 = (v[4 * j + 3] - mean) * rstd * (1.f + scl.w) + sh.w;
        uint2 o2; o2.x = pk2(a0, a1); o2.y = pk2(a2, a3);
        *(uint2*)(P.u + (size_t)row * DM + j * 256 + lane * 4) = o2;
      }
    }
  }
}

__device__ __forceinline__ int lds_byte2(int r, int c) {
  int st = (r >> 4) * 2 + (c >> 5), ob = (r & 15) * 64 + (c & 31) * 2;
  return st * 1024 + (ob ^ (((ob >> 9) & 1) << 5));
}
__device__ __forceinline__ void stage_rc2(int b, int& R, int& C) {
  int st = b >> 10, sb = b & 1023, swz = sb ^ (((sb >> 9) & 1) << 5);
  R = (st >> 1) * 16 + swz / 64;
  C = (st & 1) * 32 + (swz % 64) / 2;
}
template <int BN>
__device__ __forceinline__ void gemm_tile(const bf16_t* __restrict__ A, int lda, const bf16_t* __restrict__ BT, int ldb, int K,
                                          f32x4 (&acc)[4][BN / 32], unsigned char* smem) {
  constexpr int TA = 128 * 128, TB = BN * 128, STAGE = TA + TB, GLB = BN / 32;
  const int tid = get_tid(), lane = tid & 63, wv = tid >> 6, g = lane >> 4, r16 = lane & 15;
  const int wm = wv >> 1, wn = wv & 1;
  int ga[4], gb[GLB];
#pragma unroll
  for (int i = 0; i < 4; ++i) { int R, C; stage_rc2(wv * 1024 + i * 4096 + lane * 16, R, C); ga[i] = R * lda + C; }
#pragma unroll
  for (int i = 0; i < GLB; ++i) { int R, C; stage_rc2(wv * 1024 + i * 4096 + lane * 16, R, C); gb[i] = R * ldb + C; }
  int offA[4], offB[GLB];
#pragma unroll
  for (int mi = 0; mi < 4; ++mi) offA[mi] = lds_byte2(wm * 64 + mi * 16 + r16, g * 8);
#pragma unroll
  for (int ni = 0; ni < GLB; ++ni) offB[ni] = TA + lds_byte2(wn * (BN / 2) + ni * 16 + r16, g * 8);
#define GT_STAGE(buf, koff) do { \
    _Pragma("unroll") for (int i = 0; i < 4; ++i) \
      __builtin_amdgcn_global_load_lds((const unsigned*)(A + ga[i] + (koff)), (unsigned*)(smem + (buf) * STAGE + wv * 1024 + i * 4096), 16, 0, 0); \
    _Pragma("unroll") for (int i = 0; i < GLB; ++i) \
      __builtin_amdgcn_global_load_lds((const unsigned*)(BT + gb[i] + (koff)), (unsigned*)(smem + (buf) * STAGE + TA + wv * 1024 + i * 4096), 16, 0, 0); \
  } while (0)
  const int nt = K / 64;
  GT_STAGE(0, 0);
  asm volatile("s_waitcnt vmcnt(0)" ::: "memory");
  __syncthreads();
  for (int t = 0; t < nt; ++t) {
    const int cur = t & 1;
    if (t + 1 < nt) GT_STAGE(cur ^ 1, (t + 1) * 64);
    const unsigned char* sb = smem + cur * STAGE;
#pragma unroll
    for (int kk = 0; kk < 2; ++kk) {
      bf16x8 a[4], b[GLB];
#pragma unroll
      for (int mi = 0; mi < 4; ++mi) a[mi] = *(const bf16x8*)(sb + offA[mi] + kk * 1024);
#pragma unroll
      for (int ni = 0; ni < GLB; ++ni) b[ni] = *(const bf16x8*)(sb + offB[ni] + kk * 1024);
#pragma unroll
      for (int mi = 0; mi < 4; ++mi)
#pragma unroll
        for (int ni = 0; ni < GLB; ++ni) acc[mi][ni] = mfma16(a[mi], b[ni], acc[mi][ni]);
    }
    asm volatile("s_waitcnt vmcnt(0)" ::: "memory");
    __syncthreads();
  }
#undef GT_STAGE
}

__device__ __forceinline__ void phaseB(const Params& P, int l, unsigned char* smem) {
  const int tid = get_tid(), lane = tid & 63, wv = tid >> 6, g = lane >> 4, r16 = lane & 15;
  const int wm = wv >> 1, wn = wv & 1;
  const int ntiles = 136 * 61;
  for (int t = blockIdx.x; t < ntiles; t += gridDim.x) {
    const int nt = t / 136, mt = t % 136;
    const int m0 = mt * 128, n0 = nt * 128;
    f32x4 acc[4][4];
#pragma unroll
    for (int i = 0; i < 4; ++i)
#pragma unroll
      for (int j = 0; j < 4; ++j) acc[i][j] = (f32x4){0.f, 0.f, 0.f, 0.f};
    gemm_tile<128>(P.u + (size_t)m0 * DM, DM, WINT(l) + (size_t)n0 * DM, DM, DM, acc, smem);
    if (nt < 42) {
      bf16_t* sm = (bf16_t*)(smem + wv * 9216);
#pragma unroll
      for (int mi = 0; mi < 4; ++mi)
#pragma unroll
        for (int ni = 0; ni < 4; ++ni)
#pragma unroll
          for (int r = 0; r < 4; ++r) sm[(mi * 16 + 4 * g + r) * 72 + ni * 16 + r16] = f2bf(acc[mi][ni][r]);
      asm volatile("s_waitcnt lgkmcnt(0)" ::: "memory");
      bf16_t* gp = P.p + (size_t)(m0 + wm * 64) * PS + n0 + wn * 64 + (lane & 7) * 8;
#pragma unroll
      for (int itr = 0; itr < 8; ++itr) {
        const int row = itr * 8 + (lane >> 3);
        uint4 v = *(const uint4*)(sm + row * 72 + (lane & 7) * 8);
        *(uint4*)(gp + (size_t)row * PS) = v;
      }
      __syncthreads();
      continue;
    }
#pragma unroll
    for (int ni = 0; ni < 4; ++ni) {
      const int colb = n0 + wn * 64 + ni * 16;
      const int col = colb + r16;
#pragma unroll
      for (int mi = 0; mi < 4; ++mi) {
        const int rowb = m0 + wm * 64 + mi * 16 + 4 * g;
        f32x4 a = acc[mi][ni];
        if (colb < C_HXV) {
#pragma unroll
          for (int r = 0; r < 4; ++r) P.p[(size_t)(rowb + r) * PS + col] = f2bf(a[r]);
        } else if (colb < C_GV) {
          uint2 o; o.x = pk2(a[0], a[1]); o.y = pk2(a[2], a[3]);
          *(uint2*)(P.xvT + (size_t)(col - C_HXV) * NTOK + rowb) = o;
        } else if (colb < C_AB) {
          int b, key;
          if (rowb < NLAT) { b = rowb >> 12; key = 256 + (rowb & 4095); } else { b = (rowb - NLAT) >> 8; key = (rowb - NLAT) & 255; }
          uint2 o; o.x = pk2(a[0], a[1]); o.y = pk2(a[2], a[3]);
          if (colb < C_DV) { int cv = col - C_GV; int kvh = cv >> 7, d = cv & 127;
            *(uint2*)(P.gvT + ((size_t)(b * 2 + kvh) * 128 + d) * NKEY + key) = o;
          } else { int cv = col - C_DV; int h = cv >> 7, d = cv & 127;
            *(uint2*)(P.dvT + ((size_t)(b * 4 + h) * 128 + d) * NKEY + key) = o; }
        } else if (colb < C_MERGE) {
#pragma unroll
          for (int r = 0; r < 4; ++r) P.ab[(size_t)(rowb + r) * 16 + (col - C_AB)] = a[r];
        }
      }
    }
  }
}

__device__ __forceinline__ void attnprep_rows(const Params& P, int l, int row_begin, int row_end, int row_step) {
  const int tid = get_tid(); const int wv = tid >> 6, lane = tid & 63;
  const float* qn = P.gqa_qn + l * 128; const float* kn = P.gqa_kn + l * 128;
  const float LOG2E = 1.4426950408889634f;
  for (int row = row_begin + wv; row < row_end; row += row_step) {
    const bool isctx = row >= NLAT;
    float cg_ = 1.f, sg_ = 0.f, cd_ = 1.f, sd_ = 0.f;
    if (!isctx) {
      int t = row & 4095; float rp = (float)(t >> 6), cp = (float)(t & 63);
      { int pi = lane; float pos = (pi < 32) ? rp : cp; int j = pi & 31;
        float inv = exp2f(-(float)j * (13.287712379549449f / 32.f)); sincosf(pos * inv, &sg_, &cg_); }
      { int pi = lane & 31; float pos = (pi < 16) ? rp : cp; int j = pi & 15;
        float inv = exp2f(-(float)j * (13.287712379549449f / 16.f)); sincosf(pos * inv, &sd_, &cd_); }
    }
    bf16_t* pr = P.p + (size_t)row * PS;
    uint32_t* pg[6]; uint32_t wg[6]; uint32_t* pd[8]; uint32_t wd[8];
#pragma unroll
    for (int hh = 0; hh < 6; ++hh) { pg[hh] = (uint32_t*)(pr + ((hh < 4) ? C_GQ + hh * 128 : C_GK + (hh - 4) * 128)) + lane; wg[hh] = *pg[hh]; }
#pragma unroll
    for (int it = 0; it < 8; ++it) { int unit = (it & 3) * 2 + (lane >> 5);
      pd[it] = (uint32_t*)(pr + ((it < 4) ? C_DQ : C_DK) + unit * 64) + (lane & 31); wd[it] = *pd[it]; }
    const float qn0 = qn[2 * lane], qn1 = qn[2 * lane + 1], kn0 = kn[2 * lane], kn1 = kn[2 * lane + 1];
#pragma unroll
    for (int hh = 0; hh < 6; ++hh) {
      const bool isq = hh < 4;
      float x1 = lo2f(wg[hh]), x2 = hi2f(wg[hh]);
      float ms = wsum(x1 * x1 + x2 * x2, lane) * (1.f / 128.f);
      float rs = rsqrtf(ms + EPSV);
      x1 = x1 * rs * (isq ? qn0 : kn0); x2 = x2 * rs * (isq ? qn1 : kn1);
      float y1 = x1 * cg_ - x2 * sg_, y2 = x1 * sg_ + x2 * cg_;
      if (isq) { const float sc = 0.08838834764831845f * LOG2E; y1 *= sc; y2 *= sc; }
      wg[hh] = pk2(y1, y2);
    }
#pragma unroll
    for (int it = 0; it < 8; ++it) {
      const bool isq = it < 4;
      float x1 = lo2f(wd[it]), x2 = hi2f(wd[it]);
      float y1 = x1 * cd_ - x2 * sd_, y2 = x1 * sd_ + x2 * cd_;
      if (isq) { const float sc = 0.125f * LOG2E; y1 *= sc; y2 *= sc; }
      wd[it] = pk2(y1, y2);
    }
#pragma unroll
    for (int hh = 0; hh < 6; ++hh) *pg[hh] = wg[hh];
#pragma unroll
    for (int it = 0; it < 8; ++it) *pd[it] = wd[it];
  }
}

__device__ __forceinline__ void gdnprep_item(const Params& P, int l, int it, unsigned char* smem) {
  bf16_t* kb = (bf16_t*)smem;
  bf16_t* vb = kb + 64 * 136;
  bf16_t* qb = vb + 64 * 136;
  float* T = (float*)qb;
  float* T1 = (float*)(smem + 3 * 64 * 136 * 2);
  float* sc_cum = (float*)(smem + 3 * 64 * 136 * 2 + 16384);
  float* sc_beta = sc_cum + 128;
  float* sc_cw = sc_beta + 128;
  const int tid = get_tid(), lane = tid & 63, wv = tid >> 6, g = lane >> 4, r16 = lane & 15;
  const int ci = it >> 2, hd = it & 3;
  const int r0 = ci * 64;
  int seq0, seqn;
  if (ci < 256) { seq0 = (ci >> 6) * 4096; seqn = 4096; } else { seq0 = NLAT + ((ci - 256) >> 2) * 256; seqn = 256; }
  const float* cwt = P.gdn_conv + (size_t)l * 4 * 1536;
  __syncthreads();
#pragma unroll 3
  for (int itr = 0; itr < 12; ++itr) {
    int e = tid + 256 * itr;
    int cc = e & 15, tp = e >> 4; int tk = tp & 63, part = tp >> 6;
    int colb = part * 512 + hd * 128 + cc * 8;
    int row = r0 + tk;
    float acc[8];
#pragma unroll
    for (int j = 0; j < 8; ++j) acc[j] = 0.f;
#pragma unroll
    for (int tap = 0; tap < 4; ++tap) {
      int rr = row - 1 + tap;
      if (rr >= seq0 && rr < seq0 + seqn) {
        U128 xv; xv.u = *(const uint4*)(P.p + (size_t)rr * PS + C_GQKV + colb);
        float4 w0 = *(const float4*)(cwt + tap * 1536 + colb);
        float4 w1 = *(const float4*)(cwt + tap * 1536 + colb + 4);
        acc[0] += lo2f(xv.w[0]) * w0.x; acc[1] += hi2f(xv.w[0]) * w0.y; acc[2] += lo2f(xv.w[1]) * w0.z; acc[3] += hi2f(xv.w[1]) * w0.w;
        acc[4] += lo2f(xv.w[2]) * w1.x; acc[5] += hi2f(xv.w[2]) * w1.y; acc[6] += lo2f(xv.w[3]) * w1.z; acc[7] += hi2f(xv.w[3]) * w1.w;
      }
    }
    float ss = 0.f;
#pragma unroll
    for (int j = 0; j < 8; ++j) { acc[j] = siluf(acc[j]); ss += acc[j] * acc[j]; }
    ss += shx(ss, lane, 1); ss += shx(ss, lane, 2); ss += shx(ss, lane, 4); ss += shx(ss, lane, 8);
    float scl = 1.f;
    if (part == 0) scl = rsqrtf(ss + EPSV) * 0.08838834764831845f;
    else if (part == 1) scl = rsqrtf(ss + EPSV);
    U128 o;
#pragma unroll
    for (int j = 0; j < 4; ++j) o.w[j] = pk2(acc[2 * j] * scl, acc[2 * j + 1] * scl);
    bf16_t* dstb = (part == 0) ? qb : (part == 1 ? kb : vb);
    *(uint4*)(dstb + tk * 136 + cc * 8) = o.u;
  }
  if (tid < 128) {
    int dir = wv, i = lane; int tk = dir ? 63 - i : i; int row = r0 + tk;
    float a = P.ab[(size_t)row * 16 + dir * 4 + hd];
    float bb = P.ab[(size_t)row * 16 + 8 + dir * 4 + hd];
    float xx = a + P.gdn_dt_bias[l * 8 + dir * 4 + hd];
    float sp = (xx > 20.f) ? xx : log1pf(expf(xx));
    float gg = -expf(P.gdn_a_log[l * 8 + dir * 4 + hd]) * sp;
    float beta = 1.f / (1.f + expf(-bb));
    float cum = gg;
#pragma unroll
    for (int o = 1; o < 64; o <<= 1) { float t = __int_as_float(__builtin_amdgcn_ds_bpermute(((lane >= o) ? lane - o : lane) << 2, __float_as_int(cum))); if (lane >= o) cum += t; }
    sc_cum[dir * 64 + i] = cum; sc_beta[dir * 64 + i] = beta; sc_cw[dir * 64 + i] = beta * expf(cum);
  }
  __syncthreads();
  f32x4 akk[4], aqk[4];
#pragma unroll
  for (int j = 0; j < 4; ++j) { akk[j] = (f32x4){0.f, 0.f, 0.f, 0.f}; aqk[j] = (f32x4){0.f, 0.f, 0.f, 0.f}; }
#pragma unroll
  for (int ks = 0; ks < 4; ++ks) {
    bf16x8 ak = *(const bf16x8*)(kb + (wv * 16 + r16) * 136 + ks * 32 + g * 8);
    bf16x8 aq = *(const bf16x8*)(qb + (wv * 16 + r16) * 136 + ks * 32 + g * 8);
#pragma unroll
    for (int jt = 0; jt < 4; ++jt) {
      bf16x8 b = *(const bf16x8*)(kb + (jt * 16 + r16) * 136 + ks * 32 + g * 8);
      akk[jt] = mfma16(ak, b, akk[jt]); aqk[jt] = mfma16(aq, b, aqk[jt]);
    }
  }
  const size_t rec0 = ((size_t)ci * 4 + hd) * 2;
#pragma unroll
  for (int jt = 0; jt < 4; ++jt) {
    int j = jt * 16 + r16;
#pragma unroll
    for (int r = 0; r < 4; ++r) {
      int i = wv * 16 + 4 * g + r;
      float qk = aqk[jt][r];
      float v0 = (j <= i) ? qk * __expf(sc_cum[i] - sc_cum[j]) : 0.f;
      P.gQK[(rec0 + 0) * 4096 + i * 64 + j] = f2bf(v0);
      int i1 = 63 - i, j1 = 63 - j;
      float v1 = (j1 <= i1) ? qk * __expf(sc_cum[64 + i1] - sc_cum[64 + j1]) : 0.f;
      P.gQK[(rec0 + 1) * 4096 + i1 * 64 + j1] = f2bf(v1);
    }
  }
#pragma unroll 1
  for (int dir = 0; dir < 2; ++dir) {
    const float cl = sc_cum[dir * 64 + 63];
#pragma unroll
    for (int itr = 0; itr < 4; ++itr) {
      int e = tid + 256 * itr; int i = e >> 4, cc = e & 15; int tk = dir ? 63 - i : i;
      float sc = __expf(sc_cum[dir * 64 + i]);
      U128 xv; xv.u = *(const uint4*)(qb + tk * 136 + cc * 8);
      U128 o;
#pragma unroll
      for (int j = 0; j < 4; ++j) o.w[j] = pk2(lo2f(xv.w[j]) * sc, hi2f(xv.w[j]) * sc);
      *(uint4*)(P.gQd + (rec0 + dir) * 8192 + i * 128 + cc * 8) = o.u;
    }
#pragma unroll
    for (int itr = 0; itr < 4; ++itr) {
      int e = tid + 256 * itr; int d = e >> 3, ic = e & 7;
      float vv[8];
#pragma unroll
      for (int j = 0; j < 8; ++j) { int i = ic * 8 + j; int tk = dir ? 63 - i : i;
        vv[j] = bf2f(kb[tk * 136 + d]) * __expf(cl - sc_cum[dir * 64 + i]); }
      U128 o;
#pragma unroll
      for (int j = 0; j < 4; ++j) o.w[j] = pk2(vv[2 * j], vv[2 * j + 1]);
      *(uint4*)(P.gKtT + (rec0 + dir) * 8192 + d * 64 + ic * 8) = o.u;
    }
    if (tid == 0) P.gGl[rec0 + dir] = __expf(cl);
  }
  __syncthreads();
#pragma unroll
  for (int jt = 0; jt < 4; ++jt) {
    int j = jt * 16 + r16;
#pragma unroll
    for (int r = 0; r < 4; ++r) {
      int i = wv * 16 + 4 * g + r;
      if (j < i) T[i * 64 + j] = sc_beta[i] * akk[jt][r] * __expf(sc_cum[i] - sc_cum[j]);
      int ii = 63 - i, jj = 63 - j;
      if (jj < ii) T1[ii * 64 + jj] = sc_beta[64 + ii] * akk[jt][r] * __expf(sc_cum[64 + ii] - sc_cum[64 + jj]);
    }
  }
  __syncthreads();
  {
    const int col = tid;
    const bool isw = col < 128;
    const bf16_t* srcb = isw ? (kb + col) : (vb + (col - 128));
    const float* coef0 = isw ? sc_cw : sc_beta;
    const float* coef1 = coef0 + 64;
    float x[64], y[64];
#pragma unroll
    for (int i = 0; i < 64; ++i) {
      float a0 = bf2f(srcb[i * 136]) * coef0[i], a1 = 0.f, a2 = 0.f, a3 = 0.f;
      float b0 = bf2f(srcb[(63 - i) * 136]) * coef1[i], b1 = 0.f, b2 = 0.f, b3 = 0.f;
#pragma unroll
      for (int j4 = 0; j4 < (i + 3) / 4; ++j4) {
        float4 t4 = *(const float4*)(T + i * 64 + j4 * 4);
        float4 u4 = *(const float4*)(T1 + i * 64 + j4 * 4);
        if (j4 * 4 + 0 < i) { a0 -= t4.x * x[j4 * 4 + 0]; b0 -= u4.x * y[j4 * 4 + 0]; }
        if (j4 * 4 + 1 < i) { a1 -= t4.y * x[j4 * 4 + 1]; b1 -= u4.y * y[j4 * 4 + 1]; }
        if (j4 * 4 + 2 < i) { a2 -= t4.z * x[j4 * 4 + 2]; b2 -= u4.z * y[j4 * 4 + 2]; }
        if (j4 * 4 + 3 < i) { a3 -= t4.w * x[j4 * 4 + 3]; b3 -= u4.w * y[j4 * 4 + 3]; }
      }
      x[i] = (a0 + a1) + (a2 + a3);
      y[i] = (b0 + b1) + (b2 + b3);
    }
    if (isw) {
      bf16_t* d0 = P.gW + (rec0 + 0) * 8192 + col;
      bf16_t* d1 = P.gW + (rec0 + 1) * 8192 + col;
#pragma unroll
      for (int i = 0; i < 64; ++i) { d0[i * 128] = f2bf(x[i]); d1[i * 128] = f2bf(y[i]); }
    } else {
      uint4* d0 = (uint4*)(P.gUT + (rec0 + 0) * 8192 + (col - 128) * 64);
      uint4* d1 = (uint4*)(P.gUT + (rec0 + 1) * 8192 + (col - 128) * 64);
#pragma unroll
      for (int c8 = 0; c8 < 8; ++c8) {
        U128 o, o1;
#pragma unroll
        for (int j = 0; j < 4; ++j) { o.w[j] = pk2(x[c8 * 8 + 2 * j], x[c8 * 8 + 2 * j + 1]); o1.w[j] = pk2(y[c8 * 8 + 2 * j], y[c8 * 8 + 2 * j + 1]); }
        d0[c8] = o.u; d1[c8] = o1.u;
      }
    }
  }
  __syncthreads();
}

__device__ __forceinline__ void scan_item(const Params& P, int l, int it, unsigned char* smem) {
  bf16_t* ST0 = (bf16_t*)smem;
  bf16_t* ST1 = ST0 + 32 * 144;
  bf16_t* vnT = ST1 + 32 * 144;
  const int tid = get_tid(), lane = tid & 63, wv = tid >> 6, g = lane >> 4, r16 = lane & 15;
  const int sl = it & 3, dir = (it >> 2) & 1, hd = (it >> 3) & 3, b = it >> 5;
  __syncthreads();
  for (int e = tid; e < 32 * 144; e += 256) ST0[e] = 0;
  f32x4 S[2][2];
#pragma unroll
  for (int i = 0; i < 2; ++i)
#pragma unroll
    for (int j = 0; j < 2; ++j) S[i][j] = (f32x4){0.f, 0.f, 0.f, 0.f};
  bf16_t* cur = ST0; bf16_t* nxt = ST1;
  __syncthreads();
#define SCAN_CI(st) (((st) < 4) ? (256 + b * 4 + (dir ? 3 - (st) : (st))) : (b * 64 + (dir ? 63 - ((st) - 4) : ((st) - 4))))
#define SCAN_LOAD(PFX, st) do { \
    const int ci_ = SCAN_CI(st); const size_t rec_ = ((size_t)ci_ * 4 + hd) * 2 + dir; \
    const bf16_t* Wp_ = P.gW + rec_ * 8192 + (wv * 16 + r16) * 128 + g * 8; \
    const bf16_t* Qp_ = P.gQd + rec_ * 8192 + (wv * 16 + r16) * 128 + g * 8; \
    const bf16_t* Kp_ = P.gKtT + rec_ * 8192 + ((2 * wv) * 16 + r16) * 64 + g * 8; \
    const bf16_t* QKp_ = P.gQK + rec_ * 4096 + (wv * 16 + r16) * 64 + g * 8; \
    const bf16_t* Up_ = P.gUT + rec_ * 8192 + (sl * 32 + r16) * 64 + wv * 16 + 4 * g; \
    PFX##w0 = *(const bf16x8*)(Wp_); PFX##w1 = *(const bf16x8*)(Wp_ + 32); PFX##w2 = *(const bf16x8*)(Wp_ + 64); PFX##w3 = *(const bf16x8*)(Wp_ + 96); \
    PFX##q0 = *(const bf16x8*)(Qp_); PFX##q1 = *(const bf16x8*)(Qp_ + 32); PFX##q2 = *(const bf16x8*)(Qp_ + 64); PFX##q3 = *(const bf16x8*)(Qp_ + 96); \
    PFX##qk0 = *(const bf16x8*)(QKp_); PFX##qk1 = *(const bf16x8*)(QKp_ + 32); \
    PFX##k00 = *(const bf16x8*)(Kp_); PFX##k01 = *(const bf16x8*)(Kp_ + 32); \
    PFX##k10 = *(const bf16x8*)(Kp_ + 16 * 64); PFX##k11 = *(const bf16x8*)(Kp_ + 16 * 64 + 32); \
    PFX##u0 = *(const uint2*)(Up_); PFX##u1 = *(const uint2*)(Up_ + 16 * 64); \
    PFX##gl = P.gGl[rec_]; PFX##ci = ci_; } while (0)
  bf16x8 cw0, cw1, cw2, cw3, cq0, cq1, cq2, cq3, cqk0, cqk1, ck00, ck01, ck10, ck11; uint2 cu0, cu1; float cgl; int cci;
  bf16x8 nw0, nw1, nw2, nw3, nq0, nq1, nq2, nq3, nqk0, nqk1, nk00, nk01, nk10, nk11; uint2 nu0, nu1; float ngl; int nci;
  SCAN_LOAD(c, 0);
#pragma unroll 1
  for (int step = 0; step < 68; ++step) {
    const bool isctx = step < 4;
    const int ci = cci;
    const float gl = cgl;
    const bool wantout = !(isctx && l == 3);
    { const int sn = (step + 1 < 68) ? step + 1 : 67; SCAN_LOAD(n, sn); }
    f32x4 a1[2] = {(f32x4){0.f, 0.f, 0.f, 0.f}, (f32x4){0.f, 0.f, 0.f, 0.f}};
    f32x4 a2[2] = {(f32x4){0.f, 0.f, 0.f, 0.f}, (f32x4){0.f, 0.f, 0.f, 0.f}};
    {
      const bf16x8 awv[4] = {cw0, cw1, cw2, cw3};
      const bf16x8 aqv[4] = {cq0, cq1, cq2, cq3};
#pragma unroll
      for (int ks = 0; ks < 4; ++ks) {
#pragma unroll
        for (int nt = 0; nt < 2; ++nt) {
          bf16x8 bs = *(const bf16x8*)(cur + (nt * 16 + r16) * 144 + ks * 32 + g * 8);
          a1[nt] = mfma16(awv[ks], bs, a1[nt]);
          a2[nt] = mfma16(aqv[ks], bs, a2[nt]);
        }
      }
    }
    {
      const uint2 uu[2] = {cu0, cu1};
#pragma unroll
      for (int nt = 0; nt < 2; ++nt) {
        float v0 = lo2f(uu[nt].x) - a1[nt][0], v1 = hi2f(uu[nt].x) - a1[nt][1];
        float v2 = lo2f(uu[nt].y) - a1[nt][2], v3 = hi2f(uu[nt].y) - a1[nt][3];
        uint2 o; o.x = pk2(v0, v1); o.y = pk2(v2, v3);
        *(uint2*)(vnT + (nt * 16 + r16) * 80 + wv * 16 + 4 * g) = o;
      }
    }
    __syncthreads();
#pragma unroll
    for (int mt = 0; mt < 2; ++mt)
#pragma unroll
      for (int nt = 0; nt < 2; ++nt) S[mt][nt] = S[mt][nt] * gl;
    {
      const bf16x8 aqk[2] = {cqk0, cqk1};
      const bf16x8 akk[2][2] = {{ck00, ck01}, {ck10, ck11}};
#pragma unroll
      for (int ks = 0; ks < 2; ++ks) {
        bf16x8 bv[2];
#pragma unroll
        for (int nt = 0; nt < 2; ++nt) bv[nt] = *(const bf16x8*)(vnT + (nt * 16 + r16) * 80 + ks * 32 + g * 8);
#pragma unroll
        for (int nt = 0; nt < 2; ++nt) a2[nt] = mfma16(aqk[ks], bv[nt], a2[nt]);
#pragma unroll
        for (int mt = 0; mt < 2; ++mt)
#pragma unroll
          for (int nt = 0; nt < 2; ++nt) S[mt][nt] = mfma16(akk[mt][ks], bv[nt], S[mt][nt]);
      }
    }
    if (wantout) {
#pragma unroll
      for (int nt = 0; nt < 2; ++nt)
#pragma unroll
        for (int r = 0; r < 4; ++r) {
          int i = wv * 16 + 4 * g + r; int tok = ci * 64 + (dir ? 63 - i : i);
          P.ogdn[((size_t)dir * NTOK + tok) * 512 + hd * 128 + sl * 32 + nt * 16 + r16] = f2bf(a2[nt][r]);
        }
    }
#pragma unroll
    for (int mt = 0; mt < 2; ++mt)
#pragma unroll
      for (int nt = 0; nt < 2; ++nt) {
        uint2 o; o.x = pk2(S[mt][nt][0], S[mt][nt][1]); o.y = pk2(S[mt][nt][2], S[mt][nt][3]);
        *(uint2*)(nxt + (nt * 16 + r16) * 144 + (2 * wv + mt) * 16 + 4 * g) = o;
      }
    __syncthreads();
    bf16_t* t = cur; cur = nxt; nxt = t;
    cw0 = nw0; cw1 = nw1; cw2 = nw2; cw3 = nw3; cq0 = nq0; cq1 = nq1; cq2 = nq2; cq3 = nq3;
    cqk0 = nqk0; cqk1 = nqk1; ck00 = nk00; ck01 = nk01; ck10 = nk10; ck11 = nk11; cu0 = nu0; cu1 = nu1; cgl = ngl; cci = nci;
  }
#undef SCAN_LOAD
#undef SCAN_CI
}

template <int DQK>
__device__ __forceinline__ void attn_item(const bf16_t* __restrict__ qbase, const bf16_t* __restrict__ kbase,
                                          const bf16_t* __restrict__ vT, int b, int qrow0, int nkt,
                                          bf16_t* __restrict__ obase, int ldo, unsigned char* smem) {
  constexpr int KS = DQK / 32;
  constexpr int KROWB = DQK * 2;
  constexpr int KBYTES = 64 * KROWB;
  constexpr int STG = KBYTES + 16384;
  constexpr int RPI = 1024 / KROWB;
  constexpr int CPRK = KROWB / 16;
  const int tid = get_tid(), lane = tid & 63, wv = tid >> 6, g = lane >> 4, r16 = lane & 15;
  __syncthreads();
  bf16x8 qf[2][KS];
#pragma unroll
  for (int qt = 0; qt < 2; ++qt)
#pragma unroll
    for (int ks = 0; ks < KS; ++ks)
      qf[qt][ks] = *(const bf16x8*)(qbase + (size_t)(qrow0 + wv * 32 + qt * 16 + r16) * PS + ks * 32 + g * 8);
  int ksrc[KS], vsrc[4];
#pragma unroll
  for (int i = 0; i < KS; ++i) {
    const int row = RPI * (wv + 4 * i) + lane / CPRK, slot = lane % CPRK;
    const int c = (DQK == 128) ? (slot ^ (row & 15)) : (slot ^ ((row >> 1) & 7));
    ksrc[i] = row * PS + c * 8;
  }
#pragma unroll
  for (int i = 0; i < 4; ++i) {
    const int d = 8 * (wv + 4 * i) + (lane >> 3), slot = lane & 7;
    const int c = slot ^ ((d >> 1) & 7);
    vsrc[i] = d * NKEY + c * 8;
  }
  int koff[KS], voff[2][2];
#pragma unroll
  for (int ks = 0; ks < KS; ++ks)
    koff[ks] = r16 * KROWB + (((ks * 4 + g) ^ ((DQK == 128) ? r16 : (r16 >> 1))) * 16);
#pragma unroll
  for (int k2 = 0; k2 < 2; ++k2) {
    const int c0 = k2 * 4 + (g >> 1);
    voff[k2][0] = KBYTES + r16 * 128 + ((c0 ^ (r16 >> 1)) * 16) + (g & 1) * 8;
    voff[k2][1] = KBYTES + r16 * 128 + (((c0 + 2) ^ (r16 >> 1)) * 16) + (g & 1) * 8;
  }
#define AT_STAGE(buf, kt_) do { \
    const int kt__ = (kt_); \
    const int krow__ = (kt__ < 4) ? (NLAT + b * 256 + kt__ * 64) : (b * 4096 + (kt__ - 4) * 64); \
    const bf16_t* kg__ = kbase + (size_t)krow__ * PS; const bf16_t* vg__ = vT + kt__ * 64; \
    _Pragma("unroll") for (int i = 0; i < KS; ++i) \
      __builtin_amdgcn_global_load_lds((const unsigned*)(kg__ + ksrc[i]), (unsigned*)(smem + (buf) * STG + (wv + 4 * i) * 1024), 16, 0, 0); \
    _Pragma("unroll") for (int i = 0; i < 4; ++i) \
      __builtin_amdgcn_global_load_lds((const unsigned*)(vg__ + vsrc[i]), (unsigned*)(smem + (buf) * STG + KBYTES + (wv + 4 * i) * 1024), 16, 0, 0); \
  } while (0)
  f32x4 ao[8][2];
#pragma unroll
  for (int i = 0; i < 8; ++i) { ao[i][0] = (f32x4){0.f, 0.f, 0.f, 0.f}; ao[i][1] = (f32x4){0.f, 0.f, 0.f, 0.f}; }
  float mrun[2] = {0.f, 0.f};
  f32x4 accl[2] = {(f32x4){0.f, 0.f, 0.f, 0.f}, (f32x4){0.f, 0.f, 0.f, 0.f}};
  U128 ones; ones.w[0] = 0x3F803F80u; ones.w[1] = 0x3F803F80u; ones.w[2] = 0x3F803F80u; ones.w[3] = 0x3F803F80u;
  AT_STAGE(0, 0);
  asm volatile("s_waitcnt vmcnt(0)" ::: "memory");
  __syncthreads();
#pragma unroll 1
  for (int kt = 0; kt < nkt; ++kt) {
    const int cur = kt & 1;
    if (kt + 1 < nkt) AT_STAGE(cur ^ 1, kt + 1);
    const unsigned char* sb = smem + cur * STG;
    f32x4 sa[4][2];
    {
      const float n0 = -mrun[0], n1 = -mrun[1];
#pragma unroll
      for (int i = 0; i < 4; ++i) { sa[i][0] = (f32x4){n0, n0, n0, n0}; sa[i][1] = (f32x4){n1, n1, n1, n1}; }
    }
    bf16x8 kf[2][4];
#pragma unroll
    for (int mt = 0; mt < 4; ++mt) kf[0][mt] = *(const bf16x8*)(sb + mt * 16 * KROWB + koff[0]);
#pragma unroll
    for (int ks = 0; ks < KS; ++ks) {
      __builtin_amdgcn_sched_barrier(0);
      if (ks + 1 < KS) {
#pragma unroll
        for (int mt = 0; mt < 4; ++mt) kf[(ks + 1) & 1][mt] = *(const bf16x8*)(sb + mt * 16 * KROWB + koff[(ks + 1 < KS) ? ks + 1 : 0]);
      }
#pragma unroll
      for (int mt = 0; mt < 4; ++mt) {
        sa[mt][0] = mfma16(kf[ks & 1][mt], qf[0][ks], sa[mt][0]);
        sa[mt][1] = mfma16(kf[ks & 1][mt], qf[1][ks], sa[mt][1]);
      }
    }
    __builtin_amdgcn_sched_barrier(0);
    bf16x8 pf[2][2];
#pragma unroll
    for (int qt = 0; qt < 2; ++qt) {
      float mx = -1e30f;
#pragma unroll
      for (int mt = 0; mt < 4; ++mt)
#pragma unroll
        for (int r = 0; r < 4; ++r) mx = fmaxf(mx, sa[mt][qt][r]);
      if (kt == 0 || __any(mx > 8.f)) {
        mx = fmaxf(mx, shx(mx, lane, 16)); mx = fmaxf(mx, shx(mx, lane, 32));
        const float delta = (kt == 0) ? -mx : -fmaxf(mx, 0.f);
        const float alpha = (kt == 0) ? 1.f : __builtin_amdgcn_exp2f(delta); mrun[qt] -= delta;
        accl[qt] = accl[qt] * alpha;
#pragma unroll
        for (int dt = 0; dt < 8; ++dt) ao[dt][qt] = ao[dt][qt] * alpha;
#pragma unroll
        for (int mt = 0; mt < 4; ++mt) sa[mt][qt] = sa[mt][qt] + delta;
      }
#pragma unroll
      for (int mt = 0; mt < 4; ++mt)
#pragma unroll
        for (int r = 0; r < 4; ++r) sa[mt][qt][r] = __builtin_amdgcn_exp2f(sa[mt][qt][r]);
#pragma unroll
      for (int k2 = 0; k2 < 2; ++k2) {
        U128 pp;
        pp.w[0] = pk2(sa[2 * k2][qt][0], sa[2 * k2][qt][1]); pp.w[1] = pk2(sa[2 * k2][qt][2], sa[2 * k2][qt][3]);
        pp.w[2] = pk2(sa[2 * k2 + 1][qt][0], sa[2 * k2 + 1][qt][1]); pp.w[3] = pk2(sa[2 * k2 + 1][qt][2], sa[2 * k2 + 1][qt][3]);
        pf[qt][k2] = pp.v;
      }
    }
    U128 av[2][8];
#pragma unroll
    for (int dt = 0; dt < 8; ++dt) {
      uint2 v0 = *(const uint2*)(sb + dt * 2048 + voff[0][0]);
      uint2 v1 = *(const uint2*)(sb + dt * 2048 + voff[0][1]);
      av[0][dt].w[0] = v0.x; av[0][dt].w[1] = v0.y; av[0][dt].w[2] = v1.x; av[0][dt].w[3] = v1.y;
    }
    __builtin_amdgcn_sched_barrier(0);
#pragma unroll
    for (int dt = 0; dt < 8; ++dt) {
      uint2 v0 = *(const uint2*)(sb + dt * 2048 + voff[1][0]);
      uint2 v1 = *(const uint2*)(sb + dt * 2048 + voff[1][1]);
      av[1][dt].w[0] = v0.x; av[1][dt].w[1] = v0.y; av[1][dt].w[2] = v1.x; av[1][dt].w[3] = v1.y;
    }
#pragma unroll
    for (int dt = 0; dt < 8; ++dt) {
      ao[dt][0] = mfma16(av[0][dt].v, pf[0][0], ao[dt][0]);
      ao[dt][1] = mfma16(av[0][dt].v, pf[1][0], ao[dt][1]);
    }
    accl[0] = mfma16(ones.v, pf[0][0], accl[0]); accl[1] = mfma16(ones.v, pf[1][0], accl[1]);
    __builtin_amdgcn_sched_barrier(0);
#pragma unroll
    for (int dt = 0; dt < 8; ++dt) {
      ao[dt][0] = mfma16(av[1][dt].v, pf[0][1], ao[dt][0]);
      ao[dt][1] = mfma16(av[1][dt].v, pf[1][1], ao[dt][1]);
    }
    accl[0] = mfma16(ones.v, pf[0][1], accl[0]); accl[1] = mfma16(ones.v, pf[1][1], accl[1]);
    asm volatile("s_waitcnt vmcnt(0)" ::: "memory");
    __syncthreads();
  }
#undef AT_STAGE
#pragma unroll
  for (int qt = 0; qt < 2; ++qt) {
    const float lsum = accl[qt][0];
    float inv = 1.f / lsum;
    bf16_t* op = obase + (size_t)(qrow0 + wv * 32 + qt * 16 + r16) * ldo + 4 * g;
#pragma unroll
    for (int dt = 0; dt < 8; ++dt) {
      uint2 o; o.x = pk2(ao[dt][qt][0] * inv, ao[dt][qt][1] * inv); o.y = pk2(ao[dt][qt][2] * inv, ao[dt][qt][3] * inv);
      *(uint2*)(op + dt * 16) = o;
    }
  }
}

template <int NQ>
__device__ __forceinline__ void hyena_item(const Params& P, int l, int c, unsigned char* smem) {
  constexpr int n = NQ * 256;
  constexpr int RL = 2 * n + 256;
  constexpr int ZL = n + 256 + 16;
  bf16_t* R0 = (bf16_t*)smem; bf16_t* R1 = R0 + RL; bf16_t* Z = R1 + RL;
  const bf16_t* filt = (NQ == 16) ? FILTL(l) : FILTC(l);
  const int tid = get_tid(), lane = tid & 63, wv = tid >> 6, g = lane >> 4, r16 = lane & 15;
  const float* cw = P.hy_conv + (size_t)l * 3 * 1536;
  __syncthreads();
  for (int e = tid; e < 4 * 256; e += 256) { int bb = e >> 8, k = e & 255; Z[bb * ZL + (k < 128 ? k : n + k)] = 0; }
  {
    const float w0 = cw[1024 + c], w1 = cw[1536 + 1024 + c], w2 = cw[3072 + 1024 + c];
    const bf16_t* xr = P.xvT + (size_t)(1024 + c) * NTOK;
    for (int e = tid; e < 4 * (n / 8); e += 256) {
      int bb = e / (n / 8), t0 = (e % (n / 8)) * 8;
      int rb = (NQ == 16) ? bb * 4096 + t0 : NLAT + bb * 256 + t0;
      U128 xv; xv.u = *(const uint4*)(xr + rb);
      float xs[10];
      xs[0] = (t0 > 0) ? bf2f(xr[rb - 1]) : 0.f;
#pragma unroll
      for (int j = 0; j < 4; ++j) { xs[1 + 2 * j] = lo2f(xv.w[j]); xs[2 + 2 * j] = hi2f(xv.w[j]); }
      xs[9] = (t0 + 8 < n) ? bf2f(xr[rb + 8]) : 0.f;
      U128 o;
#pragma unroll
      for (int j = 0; j < 4; ++j) {
        float a = w0 * xs[2 * j] + w1 * xs[2 * j + 1] + w2 * xs[2 * j + 2];
        float bq = w0 * xs[2 * j + 1] + w1 * xs[2 * j + 2] + w2 * xs[2 * j + 3];
        o.w[j] = pk2(a, bq);
      }
      *(uint4*)(Z + bb * ZL + 128 + t0) = o.u;
    }
  }
  const int bb = r16 >> 2, mm = r16 & 3;
  f32x4 acc[NQ];
#pragma unroll 1
  for (int o = 0; o < 2; ++o) {
    {
      const bf16_t* src = filt + (size_t)(o * 512 + c) * (2 * n);
      for (int e = tid; e < RL / 8; e += 256) {
        int y0 = e * 8; U128 a; uint32_t nx = 0;
        if (y0 >= 128 && y0 < 128 + 2 * n) {
          a.u = *(const uint4*)(src + y0 - 128);
          if (y0 + 8 < 128 + 2 * n) nx = src[y0 - 120];
        } else { a.u = make_uint4(0, 0, 0, 0); if (y0 + 8 == 128) nx = src[0]; }
        *(uint4*)(R0 + y0) = a.u;
        U128 s;
        s.w[0] = (a.w[0] >> 16) | (a.w[1] << 16); s.w[1] = (a.w[1] >> 16) | (a.w[2] << 16);
        s.w[2] = (a.w[2] >> 16) | (a.w[3] << 16); s.w[3] = (a.w[3] >> 16) | (nx << 16);
        *(uint4*)(R1 + y0) = s.u;
      }
    }
    if (o == 1) {
#pragma unroll
      for (int qi = 0; qi < NQ; ++qi) {
        int q = wv * NQ + qi; int T0 = (q >> 1) * 128 + (q & 1) * 16; int t = T0 + 32 * mm + 4 * g;
        uint2 zz; zz.x = pk2(acc[qi][0], acc[qi][1]); zz.y = pk2(acc[qi][2], acc[qi][3]);
        *(uint2*)(Z + bb * ZL + 128 + t) = zz;
      }
    }
    __syncthreads();
#pragma unroll
    for (int qi = 0; qi < NQ; ++qi) acc[qi] = (f32x4){0.f, 0.f, 0.f, 0.f};
    {
      const int par = r16 & 1;
      const bf16_t* rbp = par ? R1 : R0;
      const uint32_t* rp = (const uint32_t*)(rbp + (n + 128 - r16 + 8 * g - par));
      const bf16_t* zp = Z + bb * ZL + 128 + 32 * mm + 8 * g;
      const uint32_t* rlow;
      if (NQ == 1) rlow = rp - ((wv >> 1) * 64 + (wv & 1) * 8);
      else rlow = rp - (((wv * NQ) >> 1) + (NQ / 2 - 1)) * 64 - 8;
      rlow += -3 * 16; zp += -3 * 32;
#define HY_OFF(qi) ((NQ == 1) ? 0 : ((NQ / 2 - 1 - ((qi) >> 1)) * 64 + (1 - ((qi) & 1)) * 8))
      if constexpr (NQ == 1) {
#pragma unroll 1
        for (int w = -3; w < n / 32; ++w) {
          bf16x8 bfr = *(const bf16x8*)(zp);
          U128 a0; a0.w[0] = rlow[0]; a0.w[1] = rlow[1]; a0.w[2] = rlow[2]; a0.w[3] = rlow[3];
          acc[0] = mfma16(a0.v, bfr, acc[0]);
          rlow += 16; zp += 32;
        }
      } else {
        const uint32_t* rb0 = rlow + 48 + 448;
        const bf16_t* z0 = zp + 96;
#define HY_LDG(dst, ptr) do { dst.w[0] = (ptr)[0]; dst.w[1] = (ptr)[1]; dst.w[2] = (ptr)[2]; dst.w[3] = (ptr)[3]; } while (0)
#pragma unroll 1
        for (int tau = -31; tau < -3; ++tau) {
          const uint32_t* ap = rb0 + 16 * tau;
          U128 g0, g1; HY_LDG(g0, ap + 8); HY_LDG(g1, ap);
#pragma unroll
          for (int d = 1; d < 8; ++d) {
            const int w = tau + 4 * d;
            if (w >= -3) {
              bf16x8 bfr = *(const bf16x8*)(z0 + 32 * w);
              acc[2 * d] = mfma16(g0.v, bfr, acc[2 * d]); acc[2 * d + 1] = mfma16(g1.v, bfr, acc[2 * d + 1]);
            }
          }
        }
        {
          U128 g0, g1, ng0, ng1; bf16x8 bA[4], bB[4];
          { const uint32_t* ap = rb0 + 16 * (-3); HY_LDG(g0, ap + 8); HY_LDG(g1, ap); }
#pragma unroll
          for (int d = 0; d < 4; ++d) bA[d] = *(const bf16x8*)(z0 + 32 * (-3 + 4 * d));
#pragma unroll 1
          for (int tau = -3; tau < 100; ++tau) {
            const bf16_t* zt = z0 + 32 * tau;
            __builtin_amdgcn_sched_barrier(0);
#pragma unroll
            for (int d = 0; d < 4; ++d) bB[d] = *(const bf16x8*)(zt + 32 * 4 * (d + 4));
#pragma unroll
            for (int d = 0; d < 4; ++d) { acc[2 * d] = mfma16(g0.v, bA[d], acc[2 * d]); acc[2 * d + 1] = mfma16(g1.v, bA[d], acc[2 * d + 1]); }
            __builtin_amdgcn_sched_barrier(0);
            { const uint32_t* ap = rb0 + 16 * (tau + 1); HY_LDG(ng0, ap + 8); HY_LDG(ng1, ap); }
#pragma unroll
            for (int d = 0; d < 4; ++d) bA[d] = *(const bf16x8*)(zt + 32 + 32 * 4 * d);
#pragma unroll
            for (int d = 0; d < 4; ++d) { acc[2 * (d + 4)] = mfma16(g0.v, bB[d], acc[2 * (d + 4)]); acc[2 * (d + 4) + 1] = mfma16(g1.v, bB[d], acc[2 * (d + 4) + 1]); }
            g0 = ng0; g1 = ng1;
          }
          __builtin_amdgcn_sched_barrier(0);
        }
#pragma unroll 1
        for (int tau = 100; tau < 128; ++tau) {
          const uint32_t* ap = rb0 + 16 * tau;
          U128 g0, g1; HY_LDG(g0, ap + 8); HY_LDG(g1, ap);
#pragma unroll
          for (int d = 0; d < 7; ++d) {
            const int w = tau + 4 * d;
            if (w <= 127) {
              bf16x8 bfr = *(const bf16x8*)(z0 + 32 * w);
              acc[2 * d] = mfma16(g0.v, bfr, acc[2 * d]); acc[2 * d + 1] = mfma16(g1.v, bfr, acc[2 * d + 1]);
            }
          }
        }
#undef HY_LDG
      }
#undef HY_OFF
    }
    int vz = 0; asm volatile("" : "+v"(vz));
    const int xch = (o == 0) ? c : 512 + c;
    const bf16_t* xr = P.xvT + (size_t)xch * NTOK;
    uint2 xq[NQ]; uint32_t xe[NQ];
    {
      const int q0 = wv * NQ; const int T00 = (q0 >> 1) * 128 + (q0 & 1) * 16;
      const int tb = T00 + 32 * mm + 4 * g + vz;
      const bf16_t* xb = xr + ((NQ == 16) ? bb * 4096 : NLAT + bb * 256) + tb;
#pragma unroll
      for (int qi = 0; qi < NQ; ++qi) {
        const int toff = (qi >> 1) * 128 + (qi & 1) * 16;
        const int t = tb + toff;
        xq[qi] = *(const uint2*)(xb + toff);
        uint32_t pv, nv;
        if (qi > 0) pv = (uint32_t)xb[toff - 1];
        else { pv = (uint32_t)xb[(t > 0) ? -1 : 0]; pv = (t > 0) ? pv : 0u; }
        if (qi + 1 < NQ) nv = (uint32_t)xb[toff + 4];
        else { nv = (uint32_t)xb[(t + 4 < n) ? toff + 4 : toff]; nv = (t + 4 < n) ? nv : 0u; }
        xe[qi] = pv | (nv << 16);
      }
    }
    __builtin_amdgcn_sched_barrier(0);
    const float bias = P.hy_bias[(l * 2 + o) * 512 + c];
    const float w0 = cw[xch], w1 = cw[1536 + xch], w2 = cw[3072 + xch];
#pragma unroll
    for (int qi = 0; qi < NQ; ++qi) {
      int q = wv * NQ + qi; int T0 = (q >> 1) * 128 + (q & 1) * 16; int t = T0 + 32 * mm + 4 * g + vz;
      U64 zv; zv.u = *(const uint2*)(Z + bb * ZL + 128 + t);
      int rb = (NQ == 16) ? bb * 4096 + t : NLAT + bb * 256 + t;
      float xs[6];
      xs[0] = lo2f(xe[qi]);
      xs[1] = lo2f(xq[qi].x); xs[2] = hi2f(xq[qi].x); xs[3] = lo2f(xq[qi].y); xs[4] = hi2f(xq[qi].y);
      xs[5] = hi2f(xe[qi]);
      float zf[4] = {lo2f(zv.w[0]), hi2f(zv.w[0]), lo2f(zv.w[1]), hi2f(zv.w[1])};
      float res[4];
#pragma unroll
      for (int r = 0; r < 4; ++r) {
        float yv = acc[qi][r] + zf[r] * bias;
        float xc = w0 * xs[r] + w1 * xs[r + 1] + w2 * xs[r + 2];
        res[r] = xc * yv;
      }
      if (o == 0) { acc[qi] = (f32x4){res[0], res[1], res[2], res[3]}; }
      else {
#pragma unroll
        for (int r = 0; r < 4; ++r) P.ybraw[(size_t)(rb + r) * 512 + c] = f2bf(res[r]);
      }
      __builtin_amdgcn_sched_barrier(0);
    }
    __syncthreads();
  }
}

__device__ __forceinline__ void phaseE0(const Params& P, int l) {
  const int tid = get_tid(); const int wv = tid >> 6, lane = tid & 63;
  const int nrows = (l == 3) ? NLAT : NTOK;
  const float lam_init = 0.8f - 0.6f * expf(-0.3f * (float)l);
  float lam;
  {
    const float* dl = P.diff_lam + l * 256;
    float s1 = wsum(dl[lane] * dl[64 + lane], lane);
    float s2 = wsum(dl[128 + lane] * dl[192 + lane], lane);
    lam = expf(s1) - expf(s2) + lam_init;
  }
  const int d0 = (lane & 15) * 8;
  float gnw[8], dnw[8];
#pragma unroll
  for (int j = 0; j < 8; ++j) { gnw[j] = P.gdn_norm[l * 128 + d0 + j]; dnw[j] = P.diff_norm[l * 128 + d0 + j]; }
  for (int row = blockIdx.x * 4 + wv; row < nrows; row += gridDim.x * 4) {
    const bf16_t* pr = P.p + (size_t)row * PS;
    bf16_t* yr = P.y + (size_t)row * 2048;
    const int h = lane >> 4;
    U128 af, ab_, ag, bf_, bg, cf, cgt, o1, o2, dg;
    af.u = *(const uint4*)(P.ogdn + (size_t)row * 512 + lane * 8);
    ab_.u = *(const uint4*)(P.ogdn + ((size_t)NTOK + row) * 512 + lane * 8);
    ag.u = *(const uint4*)(pr + C_GGATE + lane * 8);
    bf_.u = *(const uint4*)(P.ybraw + (size_t)row * 512 + lane * 8);
    bg.u = *(const uint4*)(pr + C_HGATE + lane * 8);
    cf.u = *(const uint4*)(P.gqao + (size_t)row * 512 + lane * 8);
    cgt.u = *(const uint4*)(pr + C_GGT + lane * 8);
    o1.u = *(const uint4*)(P.diffo + (size_t)row * 1024 + (2 * h) * 128 + d0);
    o2.u = *(const uint4*)(P.diffo + (size_t)row * 1024 + (2 * h + 1) * 128 + d0);
    dg.u = *(const uint4*)(pr + C_DGT + lane * 8);
    U128 ya, yb, yc, yd;
    {
      float o[8]; float ss = 0.f;
#pragma unroll
      for (int j = 0; j < 4; ++j) {
        o[2 * j] = lo2f(af.w[j]) + lo2f(ab_.w[j]); o[2 * j + 1] = hi2f(af.w[j]) + hi2f(ab_.w[j]);
        ss += o[2 * j] * o[2 * j] + o[2 * j + 1] * o[2 * j + 1];
      }
      ss += shx(ss, lane, 1); ss += shx(ss, lane, 2); ss += shx(ss, lane, 4); ss += shx(ss, lane, 8);
      float rs = rsqrtf(ss * (1.f / 128.f) + EPSV);
#pragma unroll
      for (int j = 0; j < 4; ++j)
        ya.w[j] = pk2(o[2 * j] * rs * gnw[2 * j] * siluf(lo2f(ag.w[j])), o[2 * j + 1] * rs * gnw[2 * j + 1] * siluf(hi2f(ag.w[j])));
    }
#pragma unroll
    for (int j = 0; j < 4; ++j) {
      yb.w[j] = pk2(lo2f(bf_.w[j]) * siluf(lo2f(bg.w[j])), hi2f(bf_.w[j]) * siluf(hi2f(bg.w[j])));
      yc.w[j] = pk2(lo2f(cf.w[j]) * siluf(lo2f(cgt.w[j])), hi2f(cf.w[j]) * siluf(hi2f(cgt.w[j])));
    }
    {
      float o[8]; float ss = 0.f;
#pragma unroll
      for (int j = 0; j < 4; ++j) {
        o[2 * j] = lo2f(o1.w[j]) - lam * lo2f(o2.w[j]); o[2 * j + 1] = hi2f(o1.w[j]) - lam * hi2f(o2.w[j]);
        ss += o[2 * j] * o[2 * j] + o[2 * j + 1] * o[2 * j + 1];
      }
      ss += shx(ss, lane, 1); ss += shx(ss, lane, 2); ss += shx(ss, lane, 4); ss += shx(ss, lane, 8);
      float rs = rsqrtf(ss * (1.f / 128.f) + EPSV) * (1.f - lam_init);
#pragma unroll
      for (int j = 0; j < 4; ++j)
        yd.w[j] = pk2(o[2 * j] * rs * dnw[2 * j] * siluf(lo2f(dg.w[j])), o[2 * j + 1] * rs * dnw[2 * j + 1] * siluf(hi2f(dg.w[j])));
    }
    *(uint4*)(yr + lane * 8) = ya.u;
    *(uint4*)(yr + 512 + lane * 8) = yb.u;
    *(uint4*)(yr + 1024 + lane * 8) = yc.u;
    *(uint4*)(yr + 1536 + lane * 8) = yd.u;
  }
}

__device__ __forceinline__ void phaseE1(const Params& P, int l, unsigned char* smem) {
  const int tid = get_tid(), lane = tid & 63, wv = tid >> 6, g = lane >> 4, r16 = lane & 15;
  const int wm = wv >> 1, wn = wv & 1;
  const int mtiles = (l == 3) ? 128 : 136;
  const int ntiles = mtiles * 16;
  for (int t = blockIdx.x; t < ntiles; t += gridDim.x) {
    const int nt = t / mtiles, mt = t % mtiles;
    const int m0 = mt * 128, n0 = nt * 64;
    f32x4 tot[4][2];
#pragma unroll
    for (int i = 0; i < 4; ++i) { tot[i][0] = (f32x4){0.f, 0.f, 0.f, 0.f}; tot[i][1] = (f32x4){0.f, 0.f, 0.f, 0.f}; }
#pragma unroll 1
    for (int br = 0; br < 4; ++br) {
      f32x4 ag[4][2], ap[4][2];
#pragma unroll
      for (int i = 0; i < 4; ++i) { ag[i][0] = (f32x4){0.f, 0.f, 0.f, 0.f}; ag[i][1] = ag[i][0]; ap[i][0] = ag[i][0]; ap[i][1] = ag[i][0]; }
      gemm_tile<64>(P.u + (size_t)m0 * DM, DM, WINT(l) + (size_t)(C_MERGE + br * 1024 + n0) * DM, DM, DM, ag, smem);
      gemm_tile<64>(P.y + (size_t)m0 * 2048 + br * 512, 2048, WBRT(l) + ((size_t)br * 1024 + n0) * 512, 512, 512, ap, smem);
#pragma unroll
      for (int i = 0; i < 4; ++i)
#pragma unroll
        for (int j = 0; j < 2; ++j)
#pragma unroll
          for (int r = 0; r < 4; ++r) tot[i][j][r] += sigmf(ag[i][j][r]) * ap[i][j][r];
    }
    {
      bf16_t* sm = (bf16_t*)(smem + wv * 5120);
#pragma unroll
      for (int mi = 0; mi < 4; ++mi)
#pragma unroll
        for (int ni = 0; ni < 2; ++ni)
#pragma unroll
          for (int r = 0; r < 4; ++r) sm[(mi * 16 + 4 * g + r) * 40 + ni * 16 + r16] = f2bf(tot[mi][ni][r]);
      asm volatile("s_waitcnt lgkmcnt(0)" ::: "memory");
      bf16_t* gp = P.s + (size_t)(m0 + wm * 64) * DM + n0 + wn * 32 + (lane & 3) * 8;
#pragma unroll
      for (int itr = 0; itr < 4; ++itr) {
        const int row = itr * 16 + (lane >> 2);
        uint4 v = *(const uint4*)(sm + row * 40 + (lane & 3) * 8);
        *(uint4*)(gp + (size_t)row * DM) = v;
      }
      __syncthreads();
    }
  }
}
__device__ __forceinline__ void phaseE2(const Params& P, int l, unsigned char* smem) {
  const int tid = get_tid(), lane = tid & 63, wv = tid >> 6, g = lane >> 4, r16 = lane & 15;
  const int wm = wv >> 1, wn = wv & 1;
  const int mtiles = (l == 3) ? 128 : 136;
  const int ntiles = mtiles * 16;
  for (int t = blockIdx.x; t < ntiles; t += gridDim.x) {
    const int nt = t / mtiles, mt = t % mtiles;
    const int m0 = mt * 128, n0 = nt * 64;
    f32x4 acc[4][2];
#pragma unroll
    for (int i = 0; i < 4; ++i) { acc[i][0] = (f32x4){0.f, 0.f, 0.f, 0.f}; acc[i][1] = (f32x4){0.f, 0.f, 0.f, 0.f}; }
    gemm_tile<64>(P.s + (size_t)m0 * DM, DM, WOUTT(l) + (size_t)n0 * DM, DM, DM, acc, smem);
    {
      float* sm = (float*)(smem + wv * 9216);
#pragma unroll
      for (int mi = 0; mi < 4; ++mi)
#pragma unroll
        for (int ni = 0; ni < 2; ++ni)
#pragma unroll
          for (int r = 0; r < 4; ++r) sm[(mi * 16 + 4 * g + r) * 36 + ni * 16 + r16] = acc[mi][ni][r];
      asm volatile("s_waitcnt lgkmcnt(0)" ::: "memory");
      float* gp = P.outf + (size_t)(m0 + wm * 64) * DM + n0 + wn * 32 + (lane & 7) * 4;
#pragma unroll
      for (int itr = 0; itr < 8; ++itr) {
        const int row = itr * 8 + (lane >> 3);
        float4 v = *(const float4*)(sm + row * 36 + (lane & 7) * 4);
        *(float4*)(gp + (size_t)row * DM) = v;
      }
      __syncthreads();
    }
  }
}

__device__ __forceinline__ void phaseD(const Params& P, int l, unsigned char* smem, unsigned xcd, unsigned* cbase) {
  int* slot = (int*)(smem + SMEM_BYTES - 16);
  const int n_scan = 16, n_hl = 64, n_gl = 64, n_dl = 128;
  const int n_hc = (l < 3) ? 64 : 0, n_gc = (l < 3) ? 4 : 0, n_dc = (l < 3) ? 8 : 0;
  const int n_main = n_scan + n_hl + n_gl + n_dl + n_hc + n_gc + n_dc;
  const int total = n_main;
#pragma unroll 1
  for (int rr = 0; rr < 8; ++rr) {
    const int x = (int)((xcd + rr) & 7u);
    unsigned* qctr = cbase + l * 8 + x;
    while (true) {
      __syncthreads();
      if (threadIdx.x == 0) *slot = (int)atomicAdd(qctr, 1u);
      __syncthreads();
      int it = *slot;
      if (it >= total) break;
      if (it >= n_main) {
        const int j = it - n_main;
        if (j < 34) CALL_FILT(filt_item(P, l + 1, x * 34 + j, smem)); else convert_item(P, l + 1, x * 466 + (j - 34), smem);
        continue;
      }
      if (it < n_scan) { CALL_SCAN(scan_item(P, l, x * 16 + it, smem)); continue; }
      it -= n_scan;
      if (it < n_hl) { CALL_HY(hyena_item<16>(P, l, x * 64 + it, smem)); continue; }
      it -= n_hl;
      if (it < n_gl) {
        const int b = x >> 1, kvh = x & 1, h = kvh * 2 + (it >> 5), qb = it & 31;
        CALL_ATT(attn_item<128>(P.p + C_GQ + h * 128, P.p + C_GK + kvh * 128, P.gvT + (size_t)(b * 2 + kvh) * 128 * NKEY, b,
                       b * 4096 + qb * 128, 68, P.gqao + h * 128, 512, smem));
        continue;
      }
      it -= n_gl;
      if (it < n_dl) {
        const int grp = 2 * x + (it >> 6), b = grp >> 2, h = grp & 3, un = 2 * h + ((it >> 5) & 1), qb = it & 31;
        CALL_ATT(attn_item<64>(P.p + C_DQ + un * 64, P.p + C_DK + un * 64, P.dvT + (size_t)(b * 4 + h) * 128 * NKEY, b,
                      b * 4096 + qb * 128, 68, P.diffo + un * 128, 1024, smem));
        continue;
      }
      it -= n_dl;
      if (it < n_hc) { CALL_HY(hyena_item<1>(P, l, x * 64 + it, smem)); continue; }
      it -= n_hc;
      if (it < n_gc) {
        const int b = x >> 1, kvh = x & 1, h = kvh * 2 + (it >> 1), qb = it & 1;
        CALL_ATT(attn_item<128>(P.p + C_GQ + h * 128, P.p + C_GK + kvh * 128, P.gvT + (size_t)(b * 2 + kvh) * 128 * NKEY, b,
                       NLAT + b * 256 + qb * 128, 4, P.gqao + h * 128, 512, smem));
        continue;
      }
      it -= n_gc;
      {
        const int grp = 2 * x + (it >> 2), b = grp >> 2, h = grp & 3, un = 2 * h + ((it >> 1) & 1), qb = it & 1;
        CALL_ATT(attn_item<64>(P.p + C_DQ + un * 64, P.p + C_DK + un * 64, P.dvT + (size_t)(b * 4 + h) * 128 * NKEY, b,
                      NLAT + b * 256 + qb * 128, 4, P.diffo + un * 128, 1024, smem));
      }
    }
  }
}

#define XB_TMO      128
#define XB_XCNT(j)  (256  + 64 * (j))
#define XB_XSUB(j)  (1280 + 64 * (j))
#define XB_XGEN(j)  (2304 + 64 * (j))
#define XB_TOP      3328
#define XB_TOPGEN   3392
#define XCD_BAR_WORDS 3456
#define XB_SPIN_CAP (1u << 22)
#define LAS __attribute__((address_space(3)))
__device__ __forceinline__ unsigned xb_ld(unsigned* p)              { return __hip_atomic_load(p, __ATOMIC_RELAXED, __HIP_MEMORY_SCOPE_AGENT); }
__device__ __forceinline__ unsigned xb_add(unsigned* p, unsigned v) { return __hip_atomic_fetch_add(p, v, __ATOMIC_RELAXED, __HIP_MEMORY_SCOPE_AGENT); }
__device__ __forceinline__ unsigned xb_xcc_id() { return (unsigned)__builtin_amdgcn_s_getreg((3 << 11) | 20) & 0xFu; }
#define XB_SPIN(cond, bar) do { unsigned _sp = 0; while (cond) { __builtin_amdgcn_s_sleep(1); \
    if ((++_sp & 255u) == 0u) { if (xb_ld(&(bar)[XB_TMO])) break; if (_sp > XB_SPIN_CAP) { atomicAdd(&(bar)[XB_TMO], 1u); break; } } } } while (0)
struct XcdBarrier { unsigned* bar; unsigned x; volatile LAS unsigned* st; };
__device__ __forceinline__ XcdBarrier xcd_barrier_post(unsigned* bar, volatile LAS unsigned* st) {
  XcdBarrier b; b.bar = bar; b.x = xb_xcc_id(); b.st = st;
  if (threadIdx.x == 0) (void)xb_add(&bar[XB_XCNT(b.x)], 1u);
  return b;
}
__device__ __forceinline__ void xcd_barrier_complete(unsigned* bar, unsigned x, unsigned& nloc, unsigned& nx) {
  const unsigned G = gridDim.x * gridDim.y * gridDim.z;
  unsigned sum, cnt, mine, sp = 0u;
  for (;;) {
    sum = 0u; cnt = 0u; mine = 0u;
#pragma unroll
    for (unsigned j = 0; j < 16; ++j) { const unsigned c = xb_ld(&bar[XB_XCNT(j)]); sum += c; cnt += (c > 0u) ? 1u : 0u; mine = (j == x) ? c : mine; }
    if (sum == G) break;
    __builtin_amdgcn_s_sleep(1);
    if ((++sp & 255u) == 0u) { if (xb_ld(&bar[XB_TMO])) break; if (sp > XB_SPIN_CAP) { atomicAdd(&bar[XB_TMO], 1u); break; } }
  }
  nloc = mine > 0u ? mine : 1u; nx = cnt > 0u ? cnt : 1u;
}
__device__ __forceinline__ void xcd_barrier(const XcdBarrier& b) {
  asm volatile("s_waitcnt vmcnt(0)" ::: "memory");
  __syncthreads();
  if (threadIdx.x == 0) {
    unsigned* bar = b.bar;
    __builtin_amdgcn_s_waitcnt(0);
    unsigned nloc = b.st[0], nx = b.st[1];
    if (nloc == 0u) { xcd_barrier_complete(bar, b.x, nloc, nx); b.st[0] = nloc; b.st[1] = nx; }
    const unsigned old = xb_add(&bar[XB_XSUB(b.x)], 1u);
    const unsigned gen = old / nloc;
    if (old + 1u == (gen + 1u) * nloc) {
      __builtin_amdgcn_fence(__ATOMIC_RELEASE, "agent");
      asm volatile("s_waitcnt vmcnt(0)" ::: "memory");
      const unsigned og = xb_add(&bar[XB_TOP], 1u);
      const unsigned tg = og / nx;
      if (og + 1u == (tg + 1u) * nx) xb_add(&bar[XB_TOPGEN], 1u);
      else XB_SPIN(xb_ld(&bar[XB_TOPGEN]) == tg, bar);
      __builtin_amdgcn_fence(__ATOMIC_ACQUIRE, "agent");
      xb_add(&bar[XB_XGEN(b.x)], 1u);
      asm volatile("s_waitcnt vmcnt(0)" ::: "memory");
    } else {
      XB_SPIN(xb_ld(&bar[XB_XGEN(b.x)]) == gen, bar);
      __builtin_amdgcn_fence(__ATOMIC_ACQUIRE, "agent");
      asm volatile("s_waitcnt vmcnt(0)" ::: "memory");
    }
  }
  __syncthreads();
}

__global__ void __launch_bounds__(256, 2) fwd_megakernel(Params P) {
  __shared__ __attribute__((aligned(16))) unsigned char smem[SMEM_BYTES];
  cg::grid_group grid = cg::this_grid();
  if (threadIdx.x < 2) ((volatile unsigned*)(smem + SMEM_BYTES - 32))[threadIdx.x] = 0u;
  __syncthreads();
  XcdBarrier xb = xcd_barrier_post(P.xbar, (volatile LAS unsigned*)(smem + SMEM_BYTES - 32));
  for (int it = blockIdx.x; it < 192; it += gridDim.x) mod_item(P, it, smem);
  if (P.out == nullptr) grid.sync();
  xcd_barrier(xb);
#pragma unroll 1
  for (int l = 0; l < 4; ++l) {
    phase_rows(P, l);
    if (gridDim.x == 512) {
      if (blockIdx.x < 272) { CALL_FILT(filt_item(P, l, blockIdx.x, smem)); }
      else for (int j = blockIdx.x - 272; j < 932; j += 240) convert4_item(P, l, j, smem);
    } else {
      for (int it = blockIdx.x; it < 3728 + 272; it += gridDim.x) {
        if (it < 272) { CALL_FILT(filt_item(P, l, it, smem)); } else convert_item(P, l, it - 272, smem);
      }
    }
    xcd_barrier(xb);
    CALL_B(phaseB(P, l, smem));
#ifdef PROBE_G2
    xcd_barrier(xb);
    phaseB(P, l, smem);
#endif
    xcd_barrier(xb);
    {
      int* slot = (int*)(smem + SMEM_BYTES - 16);
      unsigned* qc = P.ctr + 32 + l;
      while (true) {
        __syncthreads();
        if (threadIdx.x == 0) *slot = (int)atomicAdd(qc, 1u);
        __syncthreads();
        const int it = *slot;
        if (it >= 1088 + 544) break;
        if (it < 1088) { CALL_PREP(gdnprep_item(P, l, it, smem)); }
        else { const int r0 = (it - 1088) * 32; attnprep_rows(P, l, r0, r0 + 32, 4); }
      }
    }
    xcd_barrier(xb);
    phaseD(P, l, smem, xb.x, P.ctr);
#ifdef PROBE_D2
    xcd_barrier(xb);
    phaseD(P, l, smem, xb.x, P.ctr + 64);
#endif
    xcd_barrier(xb);
    phaseE0(P, l);
#ifdef PROBE_E02
    xcd_barrier(xb);
    phaseE0(P, l);
#endif
    xcd_barrier(xb);
    CALL_E1(phaseE1(P, l, smem));
#ifdef PROBE_G2
    xcd_barrier(xb);
    phaseE1(P, l, smem);
#endif
    xcd_barrier(xb);
    phaseE2(P, l, smem);
#ifdef PROBE_G2
    xcd_barrier(xb);
    phaseE2(P, l, smem);
#endif
    xcd_barrier(xb);
  }
  phase_rows(P, 4);
}

extern "C" void kernel_launch(void* const* d_in, const int* in_sizes, int n_in, void* d_out, int out_size, void* d_ws,
                              size_t ws_size, hipStream_t stream) {
  static int grid_blocks = 0;
  if (!grid_blocks) {
    int dev = 0, cus = 0, per_cu = 0;
    (void)hipGetDevice(&dev);
    (void)hipDeviceGetAttribute(&cus, hipDeviceAttributeMultiprocessorCount, dev);
    (void)hipOccupancyMaxActiveBlocksPerMultiprocessor(&per_cu, fwd_megakernel, 256, 0);
    if (per_cu > 2) per_cu = 2;
    if (per_cu < 1) per_cu = 1;
    grid_blocks = cus * per_cu;
  }
  Params P;
  memset(&P, 0, sizeof(P));
  const float** pin = (const float**)&P;
  for (int i = 0; i < 29; ++i) pin[i] = (const float*)d_in[i];
  P.out = (float*)d_out;
  size_t off = 0;
  auto take = [&](size_t bytes) { void* r = (char*)d_ws + off; off += (bytes + 255) & ~(size_t)255; return r; };
  P.ctr = (unsigned*)take(1024);
  P.xbar = (unsigned*)take(16384);
  P.mod = (float*)take((size_t)4 * 5 * 3072 * 4);
  P.hctx = (float*)take((size_t)NCTX * DM * 4);
  P.winT = (bf16_t*)take((size_t)2 * NIN * DM * 2);
  P.wbrT = (bf16_t*)take((size_t)2 * 4 * 1024 * 512 * 2);
  P.woutT = (bf16_t*)take((size_t)2 * 1024 * 1024 * 2);
  P.filtL = (bf16_t*)take((size_t)2 * 2 * 512 * 8192 * 2);
  P.filtC = (bf16_t*)take((size_t)2 * 2 * 512 * 512 * 2);
  P.u = (bf16_t*)take((size_t)NTOK * DM * 2);
  P.p = (bf16_t*)take((size_t)NTOK * PS * 2);
  P.xvT = (bf16_t*)take((size_t)1536 * NTOK * 2);
  P.gvT = (bf16_t*)take((size_t)4 * 2 * 128 * NKEY * 2);
  P.dvT = (bf16_t*)take((size_t)4 * 4 * 128 * NKEY * 2);
  P.ab = (float*)take((size_t)NTOK * 16 * 4);
  const size_t nrec = (size_t)272 * 4 * 2;
  char* gdn_base = (char*)d_ws + off;
  P.gW = (bf16_t*)take(nrec * 8192 * 2);
  P.gQd = (bf16_t*)take(nrec * 8192 * 2);
  P.gKtT = (bf16_t*)take(nrec * 8192 * 2);
  P.gQK = (bf16_t*)take(nrec * 4096 * 2);
  P.gUT = (bf16_t*)take(nrec * 8192 * 2);
  P.gGl = (float*)take(nrec * 4);
  P.ogdn = (bf16_t*)take((size_t)2 * NTOK * 512 * 2);
  P.ybraw = (bf16_t*)take((size_t)NTOK * 512 * 2);
  P.gqao = (bf16_t*)take((size_t)NTOK * 512 * 2);
  P.diffo = (bf16_t*)take((size_t)NTOK * 1024 * 2);
  P.y = (bf16_t*)gdn_base;
  P.outf = (float*)(gdn_base + (size_t)80 * 1024 * 1024);
  P.s = P.xvT;
  (void)hipMemsetAsync(P.ctr, 0, 1024 + 16384, stream);
  void* args[] = {&P};
  hipError_t e = hipLaunchCooperativeKernel((void*)fwd_megakernel, dim3(grid_blocks), dim3(256), args, 0, stream);
  if (e != hipSuccess) fprintf(stderr, "cooperative launch failed: %s (grid %d)\n", hipGetErrorString(e), grid_blocks);
}
```
